# Optimizing an MI355X kernel written in HIP

```python
import math
import jax, jax.numpy as jnp
from jax import lax
import numpy as np

D_MODEL = 1024
BATCH = 2
SEQ = 16384
DEPTH = 2

HEAD_DIM = 64
GRID_W = 64
NA_HEADS = 4
SW_HEADS = 6
SW_KV_HEADS = 2
AX_HEADS = 6
AX_KV_HEADS = 2
MIX_WIDTH = (NA_HEADS + SW_HEADS + AX_HEADS) * HEAD_DIM
NA_WIN_ROWS = 8
NA_WIN_COLS = 16
SW_RADIUS = 128
BLOCK = 128
T5_BUCKETS = 32
T5_MAX_DIST = 128
ROPE_THETA = 10000.0
FFN_HIDDEN = ((8 * D_MODEL + 3 * 256 - 1) // (3 * 256)) * 256
IN_SPLITS = (NA_HEADS * HEAD_DIM, NA_HEADS * HEAD_DIM, NA_HEADS * HEAD_DIM,
             SW_HEADS * HEAD_DIM, SW_KV_HEADS * HEAD_DIM, SW_KV_HEADS * HEAD_DIM,
             AX_HEADS * HEAD_DIM, AX_KV_HEADS * HEAD_DIM, AX_KV_HEADS * HEAD_DIM)
IN_WIDTH = sum(IN_SPLITS)
GROUP_WIDTHS = (NA_HEADS * HEAD_DIM, SW_HEADS * HEAD_DIM, AX_HEADS * HEAD_DIM)
EPS = 1e-6
NEG_INF = -1e30

kernel_name = "hybrid_parallel_heads_encoder"


def rms_norm(x, g):
    xf = x.astype(jnp.float32)
    y = xf * lax.rsqrt(jnp.mean(xf * xf, axis=-1, keepdims=True) + EPS)
    return (y * g.astype(jnp.float32)).astype(x.dtype)


def split_cols(t, sizes):
    out = []
    start = 0
    for s in sizes:
        out.append(t[..., start:start + s])
        start += s
    return out


def neighborhood_attention(q, k, v, rpb):
    B, S, H, d = q.shape
    rows = S // GRID_W
    kh = min(NA_WIN_ROWS, rows)
    kw = NA_WIN_COLS
    qg = q.reshape(B, rows, GRID_W, H, d)
    kg = k.reshape(B, rows, GRID_W, H, d)
    vg = v.reshape(B, rows, GRID_W, H, d)
    cols = jnp.arange(GRID_W)
    col_start = jnp.clip(cols - kw // 2, 0, GRID_W - kw)
    col_idx = col_start[:, None] + jnp.arange(kw)[None, :]
    col_off = col_idx - cols[:, None] + (NA_WIN_COLS - 1)
    scale = d ** -0.5

    def one_row(r):
        rs = jnp.clip(r - kh // 2, 0, rows - kh)
        k_band = lax.dynamic_slice_in_dim(kg, rs, kh, axis=1)
        v_band = lax.dynamic_slice_in_dim(vg, rs, kh, axis=1)
        k_nb = k_band[:, :, col_idx]
        v_nb = v_band[:, :, col_idx]
        q_row = lax.dynamic_index_in_dim(qg, r, axis=1, keepdims=False)
        s = jnp.einsum('bqhd,brqwhd->bhqrw', q_row, k_nb).astype(jnp.float32) * scale
        row_off = rs + jnp.arange(kh) - r + (NA_WIN_ROWS - 1)
        bias = rpb[:, row_off[None, :, None], col_off[:, None, :]]
        s = s + bias[None].astype(jnp.float32)
        p = jax.nn.softmax(s.reshape(B, H, GRID_W, kh * kw), axis=-1)
        p = p.reshape(B, H, GRID_W, kh, kw).astype(v.dtype)
        return jnp.einsum('bhqrw,brqwhd->bqhd', p, v_nb)

    out = lax.map(one_row, jnp.arange(rows))
    return out.transpose(1, 0, 2, 3, 4).reshape(B, S, H * d)


def t5_bucket(rel):
    nb = T5_BUCKETS // 2
    ret = (rel > 0).astype(jnp.int32) * nb
    n = jnp.abs(rel)
    max_exact = nb // 2
    nf = jnp.maximum(n, max_exact).astype(jnp.float32)
    large = max_exact + (jnp.log(nf / max_exact) / math.log(T5_MAX_DIST / max_exact)
                         * (nb - max_exact)).astype(jnp.int32)
    large = jnp.minimum(large, nb - 1)
    return ret + jnp.where(n < max_exact, n, large)


def sliding_window_attention(q, k, v, sink, t5_table):
    B, S, H, d = q.shape
    G = k.shape[2]
    R = H // G
    nb = S // BLOCK
    scale = d ** -0.5
    qb = q.reshape(B, nb, BLOCK, G, R, d)

    def band(t):
        tb = t.reshape(B, nb, BLOCK, G, d)
        pad = jnp.zeros_like(tb[:, :1])
        tp = jnp.concatenate([pad, tb, pad], axis=1)
        return jnp.concatenate([tp[:, :-2], tp[:, 1:-1], tp[:, 2:]], axis=2)

    kb = band(k)
    vb = band(v)
    qpos = jnp.arange(BLOCK)
    kpos = jnp.arange(3 * BLOCK) - BLOCK
    rel = kpos[None, :] - qpos[:, None]
    bias = t5_table[t5_bucket(rel)].astype(jnp.float32)
    bias = jnp.transpose(bias, (2, 0, 1)).reshape(G, R, BLOCK, 3 * BLOCK)
    kabs = jnp.arange(nb)[:, None] * BLOCK + kpos[None, :]
    valid = (jnp.abs(rel) <= SW_RADIUS)[None] & ((kabs >= 0) & (kabs < S))[:, None, :]
    s = jnp.einsum('bnqgrd,bnkgd->bngrqk', qb, kb).astype(jnp.float32) * scale + bias
    s = jnp.where(valid[None, :, None, None], s, NEG_INF)
    sink_logits = jnp.broadcast_to(sink.reshape(G, R, 1, 1).astype(jnp.float32), s.shape[:-1] + (1,))
    p = jax.nn.softmax(jnp.concatenate([s, sink_logits], axis=-1), axis=-1)[..., :-1]
    o = jnp.einsum('bngrqk,bnkgd->bnqgrd', p.astype(v.dtype), vb)
    return o.reshape(B, S, H * d)


def axial_rope_tables(S):
    t = jnp.arange(S)
    row = (t // GRID_W).astype(jnp.float32)
    col = (t % GRID_W).astype(jnp.float32)
    axis_dim = HEAD_DIM // 2
    freqs = ROPE_THETA ** (-jnp.arange(0, axis_dim, 2, dtype=jnp.float32) / axis_dim)
    ang = jnp.stack([row[:, None] * freqs, col[:, None] * freqs], axis=1)
    return jnp.cos(ang), jnp.sin(ang)


def apply_axial_rope(x, cos, sin):
    B, S, H, d = x.shape
    xr = x.reshape(B, S, H, 2, 2, d // 4).astype(jnp.float32)
    x1 = xr[..., 0, :]
    x2 = xr[..., 1, :]
    c = cos[None, :, None]
    s = sin[None, :, None]
    out = jnp.stack([x1 * c - x2 * s, x2 * c + x1 * s], axis=-2)
    return out.reshape(B, S, H, d).astype(x.dtype)


def axial_attention(q, k, v, gq, gk):
    B, S, H, d = q.shape
    G = k.shape[2]
    R = H // G
    nb = S // BLOCK
    scale = d ** -0.5
    cos, sin = axial_rope_tables(S)
    q = apply_axial_rope(rms_norm(q, gq), cos, sin)
    k = apply_axial_rope(rms_norm(k, gk), cos, sin)
    qb = q.reshape(B, nb, BLOCK, G, R, d).transpose(1, 0, 2, 3, 4, 5)

    def one_block(qblk):
        s = jnp.einsum('bqgrd,bkgd->bgrqk', qblk, k).astype(jnp.float32) * scale
        p = jax.nn.softmax(s, axis=-1).astype(v.dtype)
        return jnp.einsum('bgrqk,bkgd->bqgrd', p, v)

    o = lax.map(one_block, qb)
    return o.transpose(1, 0, 2, 3, 4, 5).reshape(B, S, H * d)


def setup_inputs(seed: int = 0) -> dict:
    key = jax.random.key(seed)
    ks = jax.random.split(key, 18)
    D = D_MODEL
    L = DEPTH
    F = FFN_HIDDEN

    def nrm(k, shape, scale):
        return jax.random.normal(k, shape, jnp.float32) * scale

    return {
        "x": nrm(ks[0], (BATCH, SEQ, D), 1.0),
        "c": nrm(ks[1], (BATCH, D), 1.0),
        "w_mod": nrm(ks[2], (L, D, 6 * D), 0.5 * D ** -0.5),
        "b_mod": nrm(ks[3], (L, 6 * D), 0.01),
        "g_attn": 1.0 + nrm(ks[4], (L, D), 0.01),
        "w_in": nrm(ks[5], (L, D, IN_WIDTH), D ** -0.5),
        "rpb_na": nrm(ks[6], (L, NA_HEADS, 2 * NA_WIN_ROWS - 1, 2 * NA_WIN_COLS - 1), 0.1),
        "sink_sw": nrm(ks[7], (L, SW_HEADS), 0.5),
        "t5_table": nrm(ks[8], (T5_BUCKETS, SW_HEADS), 0.1),
        "gq_ax": 1.0 + nrm(ks[9], (L, HEAD_DIM), 0.01),
        "gk_ax": 1.0 + nrm(ks[10], (L, HEAD_DIM), 0.01),
        "g_group": 1.0 + nrm(ks[11], (L, MIX_WIDTH), 0.01),
        "w_o": nrm(ks[12], (L, MIX_WIDTH, D), MIX_WIDTH ** -0.5),
        "g_ffn": 1.0 + nrm(ks[13], (L, D), 0.01),
        "w_gu": nrm(ks[14], (L, D, 2 * F), D ** -0.5),
        "w_down": nrm(ks[15], (L, F, D), F ** -0.5),
        "g_final": 1.0 + nrm(ks[16], (D,), 0.01),
    }


def reference(x, c, w_mod, b_mod, g_attn, w_in, rpb_na, sink_sw, t5_table, gq_ax, gk_ax,
              g_group, w_o, g_ffn, w_gu, w_down, g_final):
    B, S, D = x.shape
    cond = jax.nn.silu(c)
    for l in range(DEPTH):
        mod = cond @ w_mod[l] + b_mod[l]
        sh_a, sc_a, gt_a, sh_f, sc_f, gt_f = [m[:, None, :] for m in split_cols(mod, (D,) * 6)]

        h = rms_norm(x, g_attn[l]) * (1 + sc_a) + sh_a
        proj = h @ w_in[l]
        qa, ka, va, qb, kb, vb, qc, kc, vc = split_cols(proj, IN_SPLITS)
        ya = neighborhood_attention(qa.reshape(B, S, NA_HEADS, HEAD_DIM),
                                    ka.reshape(B, S, NA_HEADS, HEAD_DIM),
                                    va.reshape(B, S, NA_HEADS, HEAD_DIM), rpb_na[l])
        yb = sliding_window_attention(qb.reshape(B, S, SW_HEADS, HEAD_DIM),
                                      kb.reshape(B, S, SW_KV_HEADS, HEAD_DIM),
                                      vb.reshape(B, S, SW_KV_HEADS, HEAD_DIM),
                                      sink_sw[l], t5_table)
        yc = axial_attention(qc.reshape(B, S, AX_HEADS, HEAD_DIM),
                             kc.reshape(B, S, AX_KV_HEADS, HEAD_DIM),
                             vc.reshape(B, S, AX_KV_HEADS, HEAD_DIM), gq_ax[l], gk_ax[l])
        ga, gb, gc = split_cols(g_group[l], GROUP_WIDTHS)
        y = jnp.concatenate([rms_norm(ya, ga), rms_norm(yb, gb), rms_norm(yc, gc)], axis=-1)
        x = x + gt_a * (y @ w_o[l])

        h = rms_norm(x, g_ffn[l]) * (1 + sc_f) + sh_f
        gate, up = split_cols(h @ w_gu[l], (FFN_HIDDEN, FFN_HIDDEN))
        x = x + gt_f * ((jax.nn.silu(gate) * up) @ w_down[l])
    return rms_norm(x, g_final)
```

```cpp
#include <hip/hip_runtime.h>
#include <hip/hip_bf16.h>
#include <hip/hip_cooperative_groups.h>
#include <cstdio>
#include <cstdint>
#include <cmath>
namespace cg = cooperative_groups;

constexpr int DM = 1024, NB = 2, SEQ_ = 16384, MT = NB * SEQ_, DEPTH_ = 2, FFH = 2816, INW = 2048;
constexpr float EPS_ = 1e-6f;
constexpr float LOG2E_ = 1.4426950408889634f;

#ifndef PROBE_EPI
#define PROBE_EPI 0
#endif
namespace pg8 {
#define PG8_LAS __attribute__((address_space(3)))
typedef unsigned short bf16_t;
typedef short bf16x8 __attribute__((ext_vector_type(8)));
typedef float f32x4 __attribute__((ext_vector_type(4)));
typedef unsigned u32x4 __attribute__((ext_vector_type(4)));
constexpr int BM = 256, BK = 64, HALF = 128, HTB = HALF * BK * 2  , STAGE_BYTES = 8 * HTB, NXCD = 8, WGM = 2;

__host__ __device__ __forceinline__ int lds_byte(int r, int c) { const int st = (r >> 4) * 2 + (c >> 5), rr = r & 15, cc = c & 31, ob = rr * 64 + cc * 2; return st * 1024 + (ob ^ (((ob >> 9) & 1) << 5)); }
__host__ __device__ __forceinline__ void stage_rc(int b, int& R, int& C) { const int st = b / 1024, sb = b % 1024, swz = sb ^ (((sb >> 9) & 1) << 5); R = (st >> 1) * 16 + swz / 64; C = (st & 1) * 32 + (swz % 64) / 2; }
__host__ __device__ __forceinline__ int perm32(int rho) { const int n = rho >> 4, i = rho & 15; return 8 * (i >> 2) + 4 * n + (i & 3); }

struct Unit { int pm, pn; };
struct Gemm { const bf16_t* A; const bf16_t* Bt; int M, N, K; size_t bstride; int mhalf; };

struct StaticOrder {
    int nM, nN, nwg, G, c, swz;
    __host__ __device__ void init(int M, int N, int G_, int c_, int swz_ = 0) { nM = M / BM; nN = N / BM; nwg = nM * nN; G = G_; c = c_; swz = swz_; }
    __host__ __device__ bool next(int i, Unit& u) const {
        const long L = (long)i * G + c; if (L >= nwg) return false;
        int wgid = (int)L; { const int q = nwg / NXCD, r = nwg % NXCD, xcd = wgid % NXCD, off = wgid / NXCD; wgid = (xcd < r ? xcd * (q + 1) : r * (q + 1) + (xcd - r) * q) + off; }
        const int nig = WGM * nN, gid = wgid / nig, fm = gid * WGM, gsz = (nM - fm) < WGM ? (nM - fm) : WGM;
        u.pm = fm + ((wgid % nig) % gsz); u.pn = (wgid % nig) / gsz; if (swz && u.pn >= 4) u.pn ^= ((u.pm >> 3) & 1) << 1; return true;
    }
    __device__ __forceinline__ void a_ready(const Unit&) const {}
    __device__ __forceinline__ void done(const Unit&) const {}
};

__device__ __forceinline__ unsigned cvt_pk_bf16(float lo, float hi) { unsigned r; asm volatile("v_cvt_pk_bf16_f32 %0, %1, %2" : "=v"(r) : "v"(lo), "v"(hi)); return r; }
typedef float f32x2 __attribute__((ext_vector_type(2)));

typedef __bf16 bf16x2_t __attribute__((ext_vector_type(2)));
__device__ __forceinline__ unsigned pk_bf16(float lo, float hi) { f32x2 v = {lo, hi}; bf16x2_t b = __builtin_convertvector(v, bf16x2_t); return __builtin_bit_cast(unsigned, b); }

typedef _Float16 f16x2_t __attribute__((ext_vector_type(2)));
__device__ __forceinline__ unsigned pk_f16(float lo, float hi) { f32x2 v = {lo, hi}; f16x2_t h = __builtin_convertvector(v, f16x2_t); return __builtin_bit_cast(unsigned, h); }
__device__ __forceinline__ f32x2 up_f16(unsigned w) { return __builtin_convertvector(__builtin_bit_cast(f16x2_t, w), f32x2); }
constexpr size_t QM = 32768;
constexpr size_t OFF_QA = 0, OFF_KA = QM * 256, OFF_VA = 2 * QM * 256, OFF_QB = 3 * QM * 256, OFF_KB = OFF_QB + QM * 384, OFF_VB = OFF_KB + QM * 128,
                 OFF_QC = OFF_VB + QM * 128, OFF_KC = OFF_QC + QM * 384, OFF_VC = OFF_KC + QM * 128;

struct EpiInProj {
    static constexpr bool PERM = true, AFTER_DRAIN = false, PROBE2 = false, KHOOK = false;
    bf16_t* qkv; const float* ropec; const float* ropes; const float* gq; const float* gk; const float* rowss; const float* bias; unsigned* kmax;
    __device__ __forceinline__ void operator()(const f32x4 (&acc)[2][2][4][2], const Unit& u, int wr, int wc, int fr, int fq) const {
        const int row0 = u.pm * BM + wr * 64 + fr; const int pn = u.pn;
        int fqo = fq; asm volatile("" : "+v"(fqo));
        const float* bp = bias + (size_t)((u.pm * BM) >> 14) * 2048 + pn * BM + wc * 32 + 8 * fqo;
        if (pn < 6) {
#pragma unroll
            for (int bj = 0; bj < 2; ++bj) {
                size_t off; int pitch, c0;
                if (pn < 3) { off = (size_t)pn * QM * 256; pitch = 256; c0 = bj * 128; }
                else if (pn == 3) { off = OFF_QB; pitch = 384; c0 = bj * 128; }
                else if (pn == 4) { if (bj == 0) { off = OFF_QB; pitch = 384; c0 = 256; } else { off = OFF_KB; pitch = 128; c0 = 0; } }
                else { off = bj == 0 ? OFF_VB : OFF_VC; pitch = 128; c0 = 0; }
                bf16_t* base = qkv + off + c0 + wc * 32 + 8 * fqo;
                const f32x4 bz0 = *(const f32x4*)(bp + bj * HALF), bz1 = *(const f32x4*)(bp + bj * HALF + 4);
                const float qsc = (pn == 0 || pn == 3 || (pn == 4 && bj == 0)) ? 0.125f * 1.4426950408889634f : 1.0f;
                const bool isk = (pn == 1) || (pn == 4 && bj == 1);
                float kmx = 0.f;
#pragma unroll
                for (int ai = 0; ai < 2; ++ai)
#pragma unroll
                    for (int m = 0; m < 4; ++m) {
                        const int row = row0 + ai * HALF + m * 16;
                        const float rv = rsqrtf(rowss[row] * (1.0f / 1024.0f) + 1e-6f);
                        const f32x4 v0 = (acc[ai][bj][m][0] * rv + bz0) * qsc, v1 = (acc[ai][bj][m][1] * rv + bz1) * qsc;
                        if (isk) { float s2 = (v0[0] * v0[0] + v0[1] * v0[1]) + (v0[2] * v0[2] + v0[3] * v0[3]) + (v1[0] * v1[0] + v1[1] * v1[1]) + (v1[2] * v1[2] + v1[3] * v1[3]);
                            s2 += __shfl_xor(s2, 16); s2 += __shfl_xor(s2, 32); kmx = fmaxf(kmx, s2); }
                        u32x4 w; w.x = pk_bf16(v0[0], v0[1]); w.y = pk_bf16(v0[2], v0[3]); w.z = pk_bf16(v1[0], v1[1]); w.w = pk_bf16(v1[2], v1[3]);
                        *(u32x4*)(base + (size_t)row * pitch) = w;
                    }
                if (isk) { kmx = fmaxf(kmx, __shfl_xor(kmx, 1)); kmx = fmaxf(kmx, __shfl_xor(kmx, 2)); kmx = fmaxf(kmx, __shfl_xor(kmx, 4)); kmx = fmaxf(kmx, __shfl_xor(kmx, 8));
                    if (fr == 0 && fqo == 0) { const int grp = pn == 1 ? 0 : 1; const int head = pn == 1 ? bj * 2 + (wc >> 1) : (wc >> 1);
                        atomicMax(kmax + (grp * 4 + head) * 2 + (wc & 1), __float_as_uint(kmx * 1.02f)); } }
            }
        } else {
            const bool isq = (pn == 6) || (wc < 2);
            const int hcol = (pn == 6) ? 64 * wc : (wc < 2 ? 64 * (4 + wc) : 64 * (wc - 2));
            bf16_t* base = qkv + (isq ? OFF_QC : OFF_KC) + hcol + 8 * fqo;
            const int pitch = isq ? 384 : 128;
            const float* gw = (isq ? gq : gk) + 4 * fqo;
            const float osc = isq ? 0.125f * 1.4426950408889634f : 1.0f;
#pragma unroll
            for (int ai = 0; ai < 2; ++ai)
#pragma unroll
                for (int m = 0; m < 4; ++m) {
                    const int row = row0 + ai * HALF + m * 16; const int t = row & 16383;
                    const float rv = rsqrtf(rowss[row] * (1.0f / 1024.0f) + 1e-6f);
                    float ss = 0.f; f32x4 hv[2][2];
#pragma unroll
                    for (int bj = 0; bj < 2; ++bj)
#pragma unroll
                        for (int n = 0; n < 2; ++n) { const f32x4 v = acc[ai][bj][m][n] * rv + *(const f32x4*)(bp + bj * HALF + 4 * n); hv[bj][n] = v; ss += (v[0] * v[0] + v[1] * v[1]) + (v[2] * v[2] + v[3] * v[3]); }
                    ss += __shfl_xor(ss, 16); ss += __shfl_xor(ss, 32);
                    const float rinv = rsqrtf(ss * (1.0f / 64.0f) + 1e-6f) * osc;
#pragma unroll
                    for (int bj = 0; bj < 2; ++bj) {
                        const int pos = bj == 0 ? (t >> 6) : (t & 63);
                        const f32x4 c = *(const f32x4*)(ropec + pos * 16 + 4 * fqo), s = *(const f32x4*)(ropes + pos * 16 + 4 * fqo);
                        const f32x4 x1 = hv[bj][0] * rinv * *(const f32x4*)(gw + 32 * bj), x2 = hv[bj][1] * rinv * *(const f32x4*)(gw + 32 * bj + 16);
                        const f32x4 o1 = x1 * c - x2 * s, o2 = x2 * c + x1 * s;
                        u32x4 w; w.x = pk_bf16(o1[0], o1[1]); w.y = pk_bf16(o1[2], o1[3]); w.z = pk_bf16(o2[0], o2[1]); w.w = pk_bf16(o2[2], o2[3]);
                        *(u32x4*)(base + (size_t)row * pitch + 32 * bj) = w;
                    }
                    asm volatile("" ::: "memory");
                }
        }
    }
};

template <bool GN> struct EpiResid {
    static constexpr bool PERM = true, AFTER_DRAIN = false, PROBE2 = false, KHOOK = GN;
    const bf16_t* base; bf16_t* out; const float* gate; int gstride;
    float* rowss;
    const float* gss;
    __device__ __forceinline__ void khook(f32x4 (&acc)[2][2][4][2], const Unit& u, int t, int wr, int fr) const {
        const int row0 = u.pm * BM + wr * 64 + fr;
        const float* s0 = gss + (t == 4 ? 0 : 32768); const float w0 = t == 4 ? (1.0f / 256.0f) : (1.0f / 384.0f);
#pragma unroll
        for (int ai = 0; ai < 2; ++ai)
#pragma unroll
            for (int m = 0; m < 4; ++m) { const int row = row0 + ai * HALF + m * 16;
                const float ratio = rsqrtf(s0[row] * w0 + 1e-6f) * __builtin_sqrtf(s0[32768 + row] * (1.0f / 384.0f) + 1e-6f);
#pragma unroll
                for (int bj = 0; bj < 2; ++bj)
#pragma unroll
                    for (int n = 0; n < 2; ++n) acc[ai][bj][m][n] *= ratio; }
    }
    __device__ __forceinline__ void operator()(const f32x4 (&acc)[2][2][4][2], const Unit& u, int wr, int wc, int fr, int fq) const {
        const int row0 = u.pm * BM + wr * 64 + fr; const int b = (u.pm * BM) >> 14;
        int fqo = fq; asm volatile("" : "+v"(fqo));
        const int col0 = u.pn * BM + wc * 32 + 8 * fqo;
        float ss[2][4];
#pragma unroll
        for (int ai = 0; ai < 2; ++ai)
#pragma unroll
            for (int m = 0; m < 4; ++m) ss[ai][m] = 0.f;
#pragma unroll
        for (int bj = 0; bj < 2; ++bj) {
            f32x4 gv[2];
#pragma unroll
            for (int n = 0; n < 2; ++n) gv[n] = *(const f32x4*)(gate + (size_t)b * gstride + col0 + bj * HALF + 4 * n);
            u32x4 pq[2][4];
#pragma unroll
            for (int ai = 0; ai < 2; ++ai)
#pragma unroll
                for (int m = 0; m < 4; ++m) pq[ai][m] = *(const u32x4*)(base + (size_t)(row0 + ai * HALF + m * 16) * 1024 + col0 + bj * HALF);
            asm volatile("" ::: "memory");
#pragma unroll
            for (int ai = 0; ai < 2; ++ai) {
#pragma unroll
                for (int m = 0; m < 4; ++m) { const size_t off = (size_t)(row0 + ai * HALF + m * 16) * 1024 + col0 + bj * HALF;
                    float rc = 1.0f; if constexpr (GN) rc = rsqrtf(gss[2 * 32768 + row0 + ai * HALF + m * 16] * (1.0f / 384.0f) + 1e-6f);
                    const u32x4 q = pq[ai][m];
                    const f32x2 qa_ = up_f16(q.x), qb_ = up_f16(q.y), qc_ = up_f16(q.z), qd_ = up_f16(q.w);
                    const f32x4 x0 = (f32x4){qa_[0], qa_[1], qb_[0], qb_[1]} + gv[0] * (acc[ai][bj][m][0] * rc),
                                x1 = (f32x4){qc_[0], qc_[1], qd_[0], qd_[1]} + gv[1] * (acc[ai][bj][m][1] * rc);
                    { u32x4 wx; wx.x = pk_f16(x0[0], x0[1]); wx.y = pk_f16(x0[2], x0[3]); wx.z = pk_f16(x1[0], x1[1]); wx.w = pk_f16(x1[2], x1[3]); *(u32x4*)(out + off) = wx; }
                    ss[ai][m] += ((x0[0] * x0[0] + x0[1] * x0[1]) + (x0[2] * x0[2] + x0[3] * x0[3])) + ((x1[0] * x1[0] + x1[1] * x1[1]) + (x1[2] * x1[2] + x1[3] * x1[3]));
                }
                asm volatile("" ::: "memory");
            }
        }
#pragma unroll
        for (int ai = 0; ai < 2; ++ai)
#pragma unroll
            for (int m = 0; m < 4; ++m) { float t = ss[ai][m]; t += __shfl_xor(t, 16); t += __shfl_xor(t, 32);
                if (fq == 0) atomicAdd(rowss + row0 + ai * HALF + m * 16, t); }
    }
};

struct EpiSwiGLU {
    static constexpr bool PERM = true, AFTER_DRAIN = false, PROBE2 = true, KHOOK = false;
    bf16_t* act; const float* rowss; const float* bias;
    __device__ __forceinline__ void operator()(const f32x4 (&acc)[2][2][4][2], const Unit& u, int wr, int wc, int fr, int fq) const {
        const int row0 = u.pm * BM + wr * 64 + fr; const int col0 = u.pn * HALF + wc * 32 + 8 * fq;
        const float* bp = bias + (size_t)((u.pm * BM) >> 14) * 5632 + u.pn * BM + wc * 32 + 8 * fq;
        f32x4 bz[2][2];
#pragma unroll
        for (int bj = 0; bj < 2; ++bj)
#pragma unroll
            for (int n = 0; n < 2; ++n) bz[bj][n] = *(const f32x4*)(bp + bj * HALF + 4 * n);
#pragma unroll
        for (int ai = 0; ai < 2; ++ai)
#pragma unroll
            for (int m = 0; m < 4; ++m) {
                float o[8]; const float rv = rsqrtf(rowss[row0 + ai * HALF + m * 16] * (1.0f / 1024.0f) + 1e-6f);
#pragma unroll
                for (int n = 0; n < 2; ++n)
#pragma unroll
                    for (int j = 0; j < 4; ++j) { const float g = acc[ai][0][m][n][j] * rv + bz[0][n][j], up = acc[ai][1][m][n][j] * rv + bz[1][n][j];
                        o[4 * n + j] = g * __builtin_amdgcn_rcpf(1.0f + __expf(-g)) * up; }
                u32x4 w; w.x = pk_bf16(o[0], o[1]); w.y = pk_bf16(o[2], o[3]); w.z = pk_bf16(o[4], o[5]); w.w = pk_bf16(o[6], o[7]);
                *(u32x4*)(act + (size_t)(row0 + ai * HALF + m * 16) * 2816 + col0) = w;
            }
    }
};

typedef _Float16 f16x8_t __attribute__((ext_vector_type(8)));
template <bool F16> __device__ __forceinline__ f32x4 mma16(bf16x8 b, bf16x8 a, f32x4 c) {
    if constexpr (F16) return __builtin_amdgcn_mfma_f32_16x16x32_f16(__builtin_bit_cast(f16x8_t, b), __builtin_bit_cast(f16x8_t, a), c, 0, 0, 0);
    else return __builtin_amdgcn_mfma_f32_16x16x32_bf16(b, a, c, 0, 0, 0);
}
template <class Epi, class Sched, bool ALIGN_EPI = false, bool SP2 = false, bool F16 = false>
__device__ __forceinline__ void gemm_phase(PG8_LAS unsigned char* lds, const Gemm g, const Sched& S, const Epi& E) {
    int tid_l = threadIdx.x; asm volatile("" : "+v"(tid_l));
    const int tid = tid_l, wid = __builtin_amdgcn_readfirstlane(tid >> 6), lane = tid & 63, wr = wid >> 2, wc = wid & 3, fr = lane & 15, fq = lane >> 4;
    const int K = g.K, nt = K / BK;
    unsigned voffA[2], voffB[2];
#pragma unroll
    for (int i = 0; i < 2; ++i) { int R, C; stage_rc(tid * 16 + i * 8192, R, C); const int Rb = Epi::PERM ? ((R & ~31) + perm32(R & 31)) : R;
        voffA[i] = (unsigned)(R * K + C) * 2u; voffB[i] = (unsigned)(Rb * K + C) * 2u; }
    const size_t kstep = (size_t)(BK * 2);
    const size_t hstep = (size_t)HALF * K * 2;
    const size_t tstep = 2 * hstep;
    const unsigned ldsw = (unsigned)wid * 1024u;
    const int aoff = lds_byte(wr * 64 + fr, fq * 8), boff = lds_byte(wc * 32 + fr, fq * 8);
#define PG8_SA(b, h) (((b) * 2 + (h)) * HTB)
#define PG8_SB(b, h) ((4 + (b) * 2 + (h)) * HTB)
#define PG8_STAGE(bufoff, gbase, voff) do { _Pragma("unroll") for (int _i = 0; _i < 2; ++_i) \
        __builtin_amdgcn_global_load_lds((const unsigned*)((const char*)(gbase) + (voff)[_i]), (PG8_LAS unsigned*)(lds + (bufoff) + ldsw + _i * 8192), 16, 0, 0); } while (0)
#define PG8_LDA(dst, b, h) do { _Pragma("unroll") for (int m = 0; m < 4; ++m) _Pragma("unroll") for (int k = 0; k < 2; ++k) dst[m][k] = *(const PG8_LAS bf16x8*)(lds + PG8_SA(b, h) + aoff + m * 2048 + k * 1024); } while (0)
#define PG8_LDB(dst, b, h) do { _Pragma("unroll") for (int n = 0; n < 2; ++n) _Pragma("unroll") for (int k = 0; k < 2; ++k) dst[n][k] = *(const PG8_LAS bf16x8*)(lds + PG8_SB(b, h) + boff + n * 2048 + k * 1024); } while (0)
#define PG8_MMA(ai, bj, At, Bt) do { __builtin_amdgcn_s_setprio(1); _Pragma("unroll") for (int m = 0; m < 4; ++m) _Pragma("unroll") for (int n = 0; n < 2; ++n) _Pragma("unroll") for (int k = 0; k < 2; ++k) \
        acc[ai][bj][m][n] = mma16<F16>(Bt[n][k], At[m][k], acc[ai][bj][m][n]); __builtin_amdgcn_s_setprio(0); } while (0)
#define PG8_WAIT_V(n) asm volatile("s_waitcnt vmcnt(" #n ")" ::: "memory")
#define PG8_WAIT_L(n) asm volatile("s_waitcnt lgkmcnt(" #n ")" ::: "memory")
#define PG8_BAR __builtin_amdgcn_s_barrier()
#define PG8_SCHED __builtin_amdgcn_sched_barrier(0)
    Unit cur, nxt; int ui = 0;
    if (!S.next(0, cur)) return;
    f32x4 acc[2][2][4][2];
#pragma unroll
    for (int a = 0; a < 2; ++a)
#pragma unroll
        for (int b = 0; b < 2; ++b)
#pragma unroll
            for (int m = 0; m < 4; ++m)
#pragma unroll
                for (int n = 0; n < 2; ++n) acc[a][b][m][n] = (f32x4){0.f, 0.f, 0.f, 0.f};
    bf16x8 At[4][2], B0[2][2], B1[2][2];
    const char* cA = (const char*)g.A + (size_t)cur.pm * tstep; const char* cB = (const char*)g.Bt + (size_t)cur.pn * tstep + (cur.pm >= g.mhalf ? g.bstride : (size_t)0);
    S.a_ready(cur);
    if constexpr (SP2) {
        PG8_STAGE(PG8_SB(0, 0), cB, voffB); PG8_STAGE(PG8_SB(0, 1), cB + hstep, voffB); PG8_STAGE(PG8_SA(0, 0), cA, voffA); PG8_STAGE(PG8_SA(0, 1), cA + hstep, voffA);
        if (wr == 1) PG8_BAR;
        PG8_WAIT_V(2); PG8_BAR;
        PG8_STAGE(PG8_SB(1, 0), cB + kstep, voffB); PG8_STAGE(PG8_SA(1, 0), cA + kstep, voffA); PG8_STAGE(PG8_SB(1, 1), cB + hstep + kstep, voffB);
        PG8_WAIT_V(6); PG8_BAR;
    } else {
        PG8_STAGE(PG8_SB(0, 0), cB, voffB); PG8_STAGE(PG8_SA(0, 0), cA, voffA); PG8_STAGE(PG8_SB(0, 1), cB + hstep, voffB); PG8_STAGE(PG8_SA(0, 1), cA + hstep, voffA);
        if (wr == 1) PG8_BAR;
        PG8_WAIT_V(4); PG8_BAR;
        PG8_STAGE(PG8_SB(1, 0), cB + kstep, voffB); PG8_STAGE(PG8_SA(1, 0), cA + kstep, voffA); PG8_STAGE(PG8_SB(1, 1), cB + hstep + kstep, voffB);
        PG8_WAIT_V(6); PG8_BAR;
    }
    for (;;) {
        const bool has_next = S.next(ui + 1, nxt);
        const char* nA = has_next ? (const char*)g.A + (size_t)nxt.pm * tstep : cA; const char* nB = has_next ? (const char*)g.Bt + (size_t)nxt.pn * tstep + (nxt.pm >= g.mhalf ? g.bstride : (size_t)0) : cB;
        for (int t = 0; t < nt; t += 2) {
            if constexpr (Epi::KHOOK) { if (t == 4 || t == 10) E.khook(acc, cur, t, wr, fr); }
            const bool last = (t == nt - 2);
            const char* a1 = cA + (size_t)(t + 1) * kstep;
            const char* a2 = last ? nA : cA + (size_t)(t + 2) * kstep; const char* b2 = last ? nB : cB + (size_t)(t + 2) * kstep;
            const char* a3 = a2 + kstep; const char* b3 = b2 + kstep;
            if (last && has_next) S.a_ready(nxt);
            if constexpr (SP2) {
            PG8_LDB(B0, 0, 0); PG8_LDB(B1, 0, 1); PG8_SCHED; PG8_LDA(At, 0, 0); PG8_STAGE(PG8_SA(1, 1), a1 + hstep, voffA);
            PG8_WAIT_V(8); PG8_WAIT_L(0); PG8_BAR; PG8_MMA(0, 0, At, B0); PG8_MMA(0, 1, At, B1); PG8_BAR; PG8_SCHED;
            PG8_LDA(At, 0, 1); PG8_STAGE(PG8_SB(0, 0), b2, voffB); PG8_STAGE(PG8_SB(0, 1), b2 + hstep, voffB); PG8_STAGE(PG8_SA(0, 0), a2, voffA);
            PG8_WAIT_V(8); PG8_WAIT_L(0); PG8_BAR; PG8_MMA(1, 0, At, B0); PG8_MMA(1, 1, At, B1); PG8_BAR; PG8_SCHED;
            PG8_LDB(B0, 1, 0); PG8_LDB(B1, 1, 1); PG8_SCHED; PG8_LDA(At, 1, 0); PG8_STAGE(PG8_SA(0, 1), a2 + hstep, voffA);
            PG8_WAIT_V(8); PG8_WAIT_L(0); PG8_BAR; PG8_MMA(0, 0, At, B0); PG8_MMA(0, 1, At, B1); PG8_BAR; PG8_SCHED;
            PG8_LDA(At, 1, 1); PG8_STAGE(PG8_SB(1, 0), b3, voffB); PG8_STAGE(PG8_SB(1, 1), b3 + hstep, voffB); PG8_STAGE(PG8_SA(1, 0), a3, voffA);
            PG8_WAIT_V(8); PG8_WAIT_L(0); PG8_BAR; PG8_MMA(1, 0, At, B0); PG8_MMA(1, 1, At, B1); PG8_BAR; PG8_SCHED;
            } else {
            PG8_LDB(B0, 0, 0); PG8_SCHED; PG8_LDA(At, 0, 0); PG8_STAGE(PG8_SA(1, 1), a1 + hstep, voffA);
            PG8_WAIT_L(8); PG8_BAR; PG8_WAIT_L(0); PG8_MMA(0, 0, At, B0); PG8_BAR; PG8_SCHED;
            PG8_LDB(B1, 0, 1); PG8_STAGE(PG8_SB(0, 0), b2, voffB);
            PG8_BAR; PG8_WAIT_L(0); PG8_MMA(0, 1, At, B1); PG8_BAR;
            PG8_LDA(At, 0, 1); PG8_STAGE(PG8_SA(0, 0), a2, voffA);
            PG8_BAR; PG8_WAIT_L(0); PG8_MMA(1, 0, At, B0); PG8_BAR; PG8_SCHED;
            PG8_STAGE(PG8_SB(0, 1), b2 + hstep, voffB);
            PG8_WAIT_V(6); PG8_BAR; PG8_MMA(1, 1, At, B1); PG8_BAR;
            PG8_LDB(B0, 1, 0); PG8_SCHED; PG8_LDA(At, 1, 0); PG8_STAGE(PG8_SA(0, 1), a2 + hstep, voffA);
            PG8_WAIT_L(8); PG8_BAR; PG8_WAIT_L(0); PG8_MMA(0, 0, At, B0); PG8_BAR; PG8_SCHED;
            PG8_LDB(B1, 1, 1); PG8_STAGE(PG8_SB(1, 0), b3, voffB);
            PG8_BAR; PG8_WAIT_L(0); PG8_MMA(0, 1, At, B1); PG8_BAR;
            PG8_LDA(At, 1, 1); PG8_STAGE(PG8_SA(1, 0), a3, voffA);
            PG8_BAR; PG8_WAIT_L(0); PG8_MMA(1, 0, At, B0); PG8_BAR; PG8_SCHED;
            PG8_STAGE(PG8_SB(1, 1), b3 + hstep, voffB);
            PG8_WAIT_V(6); PG8_BAR; PG8_MMA(1, 1, At, B1); PG8_BAR;
            }
        }
        if constexpr (ALIGN_EPI) { if (wr == 0) PG8_BAR; }
        if constexpr (!Epi::AFTER_DRAIN) { E(acc, cur, wr, wc, fr, fq);
#if PROBE_EPI
            if constexpr (Epi::PROBE2) { asm volatile("" ::: "memory"); E(acc, cur, wr, wc, fr, fq); }
#endif
            S.done(cur); }
        if (!has_next) break;
#pragma unroll
        for (int a = 0; a < 2; ++a)
#pragma unroll
            for (int b = 0; b < 2; ++b)
#pragma unroll
                for (int m = 0; m < 4; ++m)
#pragma unroll
                    for (int n = 0; n < 2; ++n) acc[a][b][m][n] = (f32x4){0.f, 0.f, 0.f, 0.f};
        cur = nxt; cA = nA; cB = nB; ++ui;
        if constexpr (ALIGN_EPI) { if (wr == 1) PG8_BAR; }
    }
    PG8_WAIT_V(0);
    if constexpr (!ALIGN_EPI) { if (wr == 0) PG8_BAR; }
    PG8_BAR;
    if constexpr (Epi::AFTER_DRAIN) { E.fused(acc, cur, wr, wc, fr, fq, lds, wid, lane); S.done(cur); }
#undef PG8_SA
#undef PG8_SB
#undef PG8_STAGE
#undef PG8_LDA
#undef PG8_LDB
#undef PG8_MMA
#undef PG8_WAIT_V
#undef PG8_WAIT_L
#undef PG8_BAR
#undef PG8_SCHED
}
}
namespace attn_body {
using bf16=__hip_bfloat16;
using bf16x8=__attribute__((ext_vector_type(8)))short;
using s16x4=__attribute__((ext_vector_type(4)))short;
using f32x16=__attribute__((ext_vector_type(16)))float;
using u32x4=__attribute__((ext_vector_type(4)))unsigned;
constexpr int SEQ=16384,D=64,QP=384,KP=128,OP=1024;
constexpr int NW=8,QBLK=32,QB=QBLK*NW,KVBLK=64,NQB=SEQ/QB;
constexpr int ATTN_UNIT_ROWS=QB;
__device__ __forceinline__ int crow(int r,int hi){return (r&3)+8*(r>>2)+4*hi;}
#define SBAR() __builtin_amdgcn_sched_barrier(0)
__device__ __forceinline__ void cmask(f32x16&p0,f32x16&p1,int jb,int qrel,int hi){
  const float NEG=-INFINITY; int kb=64*jb+4*hi;
  #pragma unroll
  for(int r=0;r<16;++r){int kv=kb+(r&3)+8*(r>>2); if(kv>qrel)p0[r]=NEG; if(kv+32>qrel)p1[r]=NEG;}
}

constexpr int NSLOT=3, SLOTB=8192;
constexpr int LDS_K=0, LDS_V=NSLOT*SLOTB, LDS_WS=2*NSLOT*SLOTB, LDS_OST=LDS_WS+NW*64*4, LDS_BYTES=LDS_OST+NW*4096;
constexpr float C2=0.125f*1.4426950408889634f;
__device__ __forceinline__ void glds16(const void*gsrc,unsigned lds_dst){unsigned keep;
  asm volatile("s_mov_b32 %0, m0\n\ts_mov_b32 m0, %2\n\ts_nop 0\n\tglobal_load_lds_dwordx4 %1, off\n\ts_mov_b32 m0, %0":"=&s"(keep):"v"(gsrc),"s"(lds_dst):"memory");}
__device__ __forceinline__ float max3f(float a,float b,float c){float r;asm("v_max3_f32 %0, %1, %2, %3":"=v"(r):"v"(a),"v"(b),"v"(c));return r;}
__device__ __forceinline__ float max2f(float a,float b){float r;asm("v_max_f32_e32 %0, %1, %2":"=v"(r):"v"(a),"v"(b));return r;}
__device__ __forceinline__ float fadd_s(float a,float b){float r;asm("v_add_f32_e32 %0, %1, %2":"=v"(r):"v"(a),"v"(b));return r;}
__device__ __forceinline__ float fsub_s(float a,float b){float r;asm("v_sub_f32_e32 %0, %1, %2":"=v"(r):"v"(a),"v"(b));return r;}
typedef float f32x2_t __attribute__((ext_vector_type(2))); typedef __bf16 bf16x2_t __attribute__((ext_vector_type(2)));
__device__ __forceinline__ unsigned cvtpk_s(float lo,float hi){f32x2_t v={lo,hi};bf16x2_t b=__builtin_convertvector(v,bf16x2_t);return __builtin_bit_cast(unsigned,b);}
#define WAIT_BAR(N) asm volatile("s_waitcnt vmcnt(" #N ") lgkmcnt(0)\n\ts_barrier":::"memory")

__device__ __forceinline__ void qkt(f32x16&p0,f32x16&p1,const char*Kslot,const bf16x8*qr,const f32x16&negm,int r32,int hi){
  const char*kb=Kslot+hi*1024+r32*16;
  #pragma unroll
  for(int d0=0;d0<4;++d0){
    const bf16x8 b0=*reinterpret_cast<const bf16x8*>(kb+d0*2048);
    const bf16x8 b1=*reinterpret_cast<const bf16x8*>(kb+d0*2048+512);
    if(d0==0){p0=__builtin_amdgcn_mfma_f32_32x32x16_bf16(b0,qr[0],negm,0,0,0);p1=__builtin_amdgcn_mfma_f32_32x32x16_bf16(b1,qr[0],negm,0,0,0);}
    else{p0=__builtin_amdgcn_mfma_f32_32x32x16_bf16(b0,qr[d0],p0,0,0,0);p1=__builtin_amdgcn_mfma_f32_32x32x16_bf16(b1,qr[d0],p1,0,0,0);}}
}
typedef __attribute__((address_space(3))) const char* lds_cptr;
typedef short v4i16_t __attribute__((ext_vector_type(4)));
__device__ __forceinline__ void kload8(bf16x8*kf,lds_cptr kp){
  kf[0]=*(const __attribute__((address_space(3))) bf16x8*)(kp);      kf[1]=*(const __attribute__((address_space(3))) bf16x8*)(kp+512);
  kf[2]=*(const __attribute__((address_space(3))) bf16x8*)(kp+2048); kf[3]=*(const __attribute__((address_space(3))) bf16x8*)(kp+2560);
  kf[4]=*(const __attribute__((address_space(3))) bf16x8*)(kp+4096); kf[5]=*(const __attribute__((address_space(3))) bf16x8*)(kp+4608);
  kf[6]=*(const __attribute__((address_space(3))) bf16x8*)(kp+6144); kf[7]=*(const __attribute__((address_space(3))) bf16x8*)(kp+6656);
}
__device__ __forceinline__ void kload2(bf16x8*kf,lds_cptr kp,int j){ kf[2*j]=*(const __attribute__((address_space(3))) bf16x8*)(kp+j*2048); kf[2*j+1]=*(const __attribute__((address_space(3))) bf16x8*)(kp+j*2048+512); }
__device__ __forceinline__ s16x4 vtr(lds_cptr p){ return __builtin_bit_cast(s16x4,__builtin_amdgcn_ds_read_tr16_b64_v4i16((__attribute__((address_space(3))) v4i16_t*)p)); }
__device__ __forceinline__ float rowmax(const f32x16&p0,const f32x16&p1){
  float a=max3f(p0[0],p0[1],p1[0]),b=max3f(p0[2],p0[3],p1[1]);a=max3f(a,p1[2],p1[3]);
  #pragma unroll
  for(int r=4;r<16;r+=4){a=max3f(a,p0[r],p0[r+1]);b=max3f(b,p0[r+2],p0[r+3]);a=max3f(a,p1[r],p1[r+1]);b=max3f(b,p1[r+2],p1[r+3]);}
  const float m=max2f(a,b);
  auto rr=__builtin_amdgcn_permlane32_swap(__float_as_uint(m),__float_as_uint(m),false,false);
  return max2f(__uint_as_float(rr[0]),__uint_as_float(rr[1]));
}
__device__ __forceinline__ void pv(f32x16*o,int vb,bf16x8 pa0,bf16x8 pa1,bf16x8 pa2,bf16x8 pa3){
  #pragma unroll
  for(int d0=0;d0<2;++d0){s16x4 lo[4],hi[4];
    #pragma unroll
    for(int ks=0;ks<4;++ks){
      asm volatile("ds_read_b64_tr_b16 %0,%1 offset:%c2":"=&v"(lo[ks]):"v"(vb),"i"(d0*4096+ks*1024):"memory");
      asm volatile("ds_read_b64_tr_b16 %0,%1 offset:%c2":"=&v"(hi[ks]):"v"(vb),"i"(d0*4096+ks*1024+512):"memory");}
    asm volatile("s_waitcnt lgkmcnt(0)":::"memory");SBAR();
    #define PK(k) (bf16x8){lo[k][0],lo[k][1],lo[k][2],lo[k][3],hi[k][0],hi[k][1],hi[k][2],hi[k][3]}
    o[d0]=__builtin_amdgcn_mfma_f32_32x32x16_bf16(pa0,PK(0),o[d0],0,0,0);
    o[d0]=__builtin_amdgcn_mfma_f32_32x32x16_bf16(pa1,PK(1),o[d0],0,0,0);
    o[d0]=__builtin_amdgcn_mfma_f32_32x32x16_bf16(pa2,PK(2),o[d0],0,0,0);
    o[d0]=__builtin_amdgcn_mfma_f32_32x32x16_bf16(pa3,PK(3),o[d0],0,0,0);
    #undef PK
  }
}

#ifndef ATTN_STORE16
#define ATTN_STORE16(p,v) (*(u32x4*)(p)=(v))
#endif
template<int THRL> __device__ __forceinline__ void attn_unit(int b,int h,int qb,const bf16*Q,const bf16*__restrict__ K,const bf16*__restrict__ V,bf16*O,float*gssrow,float mref,char*shm){
  int tid_l=threadIdx.x; asm volatile("":"+v"(tid_l)); const int tid=tid_l,lane=tid&63,r32=lane&31,hi=lane>>5; const int wid=__builtin_amdgcn_readfirstlane(tid>>6);
  const long rowbase=(long)b*SEQ; const int q0=qb*QB;
  const bf16*Qw=Q+(rowbase+q0+wid*QBLK)*QP+h*D;
  const int g=h/3; const bf16*Kh=K+rowbase*KP+g*D,*Vh=V+rowbase*KP+g*D;
  const unsigned lds0=(unsigned)(uintptr_t)shm;
  float*wsf=(float*)(shm+LDS_WS)+wid*64;
  const bf16*ksrc=Kh+(long)lane*KP+wid*8;
  const bf16*vsrc=Vh+(long)(16*(wid&3)+(lane>>2))*KP+(wid>>2)*32+(lane&3)*8;
  const unsigned kdst=lds0+LDS_K+wid*1024, vdst=lds0+LDS_V+wid*1024;
  #define DMA_K(t,slot) glds16(ksrc+(long)(t)*KVBLK*KP,(unsigned)__builtin_amdgcn_readfirstlane(kdst+(slot)))
  #define DMA_V(t,slot) glds16(vsrc+(long)(t)*KVBLK*KP,(unsigned)__builtin_amdgcn_readfirstlane(vdst+(slot)))
  const int vb0=(int)(lds0+LDS_V)+((lane>>4)&1)*32+(lane&3)*8+(4*hi+((lane&15)>>2))*64;
  const char*Kbase=shm+LDS_K; bf16x8 kf[8];
  const lds_cptr shm3=(lds_cptr)shm; const lds_cptr kp0=shm3+LDS_K+hi*1024+r32*16; const lds_cptr vp0=shm3+LDS_V+((lane>>4)&1)*32+(lane&3)*8+(4*hi+((lane&15)>>2))*64;
  const int NT=SEQ/KVBLK;
  DMA_K(0,0);DMA_V(0,0);DMA_K(1,SLOTB);
  bf16x8 qr[4];
  #pragma unroll
  for(int d0=0;d0<4;++d0)qr[d0]=*reinterpret_cast<const bf16x8*>(&Qw[(long)r32*QP+d0*16+hi*8]);
  float l_reg=0.f;f32x16 o[2];o[0]=f32x16{};o[1]=f32x16{};f32x16 negm;_Pragma("unroll") for(int r=0;r<16;++r)negm[r]=-mref;asm volatile("":"+v"(negm));

  #define CMASK(P0,P1,t) do{}while(0)
  #define START(P0,P1) do{ _Pragma("unroll") for(int r=0;r<16;++r)P0[r]=__builtin_amdgcn_exp2f(P0[r]); }while(0)
  #define RESC() do{}while(0)
  f32x16 pA0,pA1,pB0,pB1;
  int sl_prev=0,sl_cur=0,sl_next=SLOTB;
  #define ROT() do{sl_prev=sl_cur;sl_cur=sl_next;sl_next=(sl_next==(NSLOT-1)*SLOTB)?0:sl_next+SLOTB;}while(0)
  DMA_K(2,2*SLOTB);
  WAIT_BAR(3);
  qkt(pA0,pA1,Kbase,qr,negm,r32,hi);asm volatile("s_nop 15\n\ts_nop 7":"+v"(pA0),"+v"(pA1));CMASK(pA0,pA1,0);
  START(pA0,pA1);
  _Pragma("unroll") for(int r=0;r<16;++r)pA1[r]=__builtin_amdgcn_exp2f(pA1[r]);
  WAIT_BAR(0);
  DMA_K(3,0);DMA_V(1,SLOTB);
  ROT();
  kload8(kf,kp0+sl_cur);
  WAIT_BAR(2);
  s16x4 vlo[8],vhi[8]; u32x4 pw0,pw1,pw2,pw3;
  #define PKW(P,B) cvtpk_s(P[B],P[B+1])
  #define PAF(k) __builtin_bit_cast(bf16x8,pw##k)
  #define VFR(i) (bf16x8){vlo[i][0],vlo[i][1],vlo[i][2],vlo[i][3],vhi[i][0],vhi[i][1],vhi[i][2],vhi[i][3]}
  #define PIN(x) asm volatile("":"+v"(x))
  #define MX3(a,b,c) __builtin_fmaxf(__builtin_fmaxf((a),(b)),(c))
  #define GAPA(MF,A0,A1,A2,A3,W0,W1,PW) do{ MF; sacc+=A0; sacc+=A1; sacc+=A2; sacc+=A3; PIN(sacc); W0; W1; PIN(PW); SBAR(); }while(0)
  #define EX(v) __builtin_amdgcn_exp2f(v)
  #define GAPB(MF,X,B) do{ MF; X[B]=EX(X[B]); X[B+1]=EX(X[B+1]); X[B+2]=EX(X[B+2]); X[B+3]=EX(X[B+3]); PIN(X); SBAR(); }while(0)
  #define VRD(i) do{ vlo[i]=vtr(vp_+(((i)>>2)*4096+((i)&3)*1024)); vhi[i]=vtr(vp_+(((i)>>2)*4096+((i)&3)*1024+512)); }while(0)
  #define KRD(G,j) do{ if(G){ kload2(kf,kp0+sl_next,j); SBAR(); } }while(0)
  #define STEP(C0,C1,P0,P1,t,GK,GV,GL) do{ SBAR(); \
    const lds_cptr vp_=vp0+sl_prev; \
    VRD(0); SBAR(); float sacc=(P0[0]+P0[1]); \
    GAPA(C0=__builtin_amdgcn_mfma_f32_32x32x16_bf16(kf[0],qr[0],negm,0,0,0), P0[2],P0[3],P0[4],P0[5],     pw0[0]=PKW(P0,0), pw0[1]=PKW(P0,2), pw0); \
    VRD(4); SBAR(); GAPA(C1=__builtin_amdgcn_mfma_f32_32x32x16_bf16(kf[1],qr[0],negm,0,0,0), P0[6],P0[7],P0[8],P0[9],     pw0[2]=PKW(P0,4), pw0[3]=PKW(P0,6), pw0); \
    VRD(1); SBAR(); GAPA(C0=__builtin_amdgcn_mfma_f32_32x32x16_bf16(kf[2],qr[1],C0,0,0,0),   P0[10],P0[11],P0[12],P0[13], pw1[0]=PKW(P0,8), pw1[1]=PKW(P0,10), pw1); \
    VRD(5); SBAR(); GAPA(C1=__builtin_amdgcn_mfma_f32_32x32x16_bf16(kf[3],qr[1],C1,0,0,0),   P0[14],P0[15],P1[0],P1[1],   pw1[2]=PKW(P0,12),pw1[3]=PKW(P0,14), pw1); \
    VRD(2); SBAR(); GAPA(C0=__builtin_amdgcn_mfma_f32_32x32x16_bf16(kf[4],qr[2],C0,0,0,0),   P1[2],P1[3],P1[4],P1[5],     pw2[0]=PKW(P1,0), pw2[1]=PKW(P1,2), pw2); \
    VRD(6); SBAR(); GAPA(C1=__builtin_amdgcn_mfma_f32_32x32x16_bf16(kf[5],qr[2],C1,0,0,0),   P1[6],P1[7],P1[8],P1[9],     pw2[2]=PKW(P1,4), pw2[3]=PKW(P1,6), pw2); \
    VRD(3); SBAR(); GAPA(C0=__builtin_amdgcn_mfma_f32_32x32x16_bf16(kf[6],qr[3],C0,0,0,0),   P1[10],P1[11],P1[12],P1[13], pw3[0]=PKW(P1,8), pw3[1]=PKW(P1,10), pw3); \
    VRD(7); SBAR(); GAPA(C1=__builtin_amdgcn_mfma_f32_32x32x16_bf16(kf[7],qr[3],C1,0,0,0),   P1[14],P1[15],0.f,0.f,       pw3[2]=PKW(P1,12),pw3[3]=PKW(P1,14), pw3); \
    l_reg+=sacc; \
    if(GK){DMA_K((t)+3,sl_cur);} if(GV){DMA_V((t)+1,sl_next);} \
    CMASK(C0,C1,t); \
    SBAR(); \
    GAPB(o[0]=__builtin_amdgcn_mfma_f32_32x32x16_bf16(PAF(0),VFR(0),o[0],0,0,0), C0,0); \
    GAPB(o[1]=__builtin_amdgcn_mfma_f32_32x32x16_bf16(PAF(0),VFR(4),o[1],0,0,0), C0,4); \
    KRD(GL,0); GAPB(o[0]=__builtin_amdgcn_mfma_f32_32x32x16_bf16(PAF(1),VFR(1),o[0],0,0,0), C0,8); \
    KRD(GL,1); GAPB(o[1]=__builtin_amdgcn_mfma_f32_32x32x16_bf16(PAF(1),VFR(5),o[1],0,0,0), C0,12); \
    KRD(GL,2); GAPB(o[0]=__builtin_amdgcn_mfma_f32_32x32x16_bf16(PAF(2),VFR(2),o[0],0,0,0), C1,0); \
    KRD(GL,3); GAPB(o[1]=__builtin_amdgcn_mfma_f32_32x32x16_bf16(PAF(2),VFR(6),o[1],0,0,0), C1,4); \
    GAPB(o[0]=__builtin_amdgcn_mfma_f32_32x32x16_bf16(PAF(3),VFR(3),o[0],0,0,0), C1,8); \
    GAPB(o[1]=__builtin_amdgcn_mfma_f32_32x32x16_bf16(PAF(3),VFR(7),o[1],0,0,0), C1,12); \
    }while(0)
  if(wid>=4)__builtin_amdgcn_s_setprio(1);
  int t=1;
  #undef CMASK
  #define CMASK(P0,P1,t) do{}while(0)
  for(;t+5<NT;t+=2){
    STEP(pB0,pB1,pA0,pA1,t,true,true,true);     WAIT_BAR(2); RESC(); ROT();
    STEP(pA0,pA1,pB0,pB1,t+1,true,true,true);   WAIT_BAR(2); RESC(); ROT();
  }
  #undef CMASK
  #define CMASK(P0,P1,t) do{}while(0)
  #define ENDW(tt) do{ if((tt)+3<NT){WAIT_BAR(2);} else if((tt)+2<NT){WAIT_BAR(1);} else {WAIT_BAR(0);} }while(0)
  for(;t+1<NT;t+=2){
    STEP(pB0,pB1,pA0,pA1,t,(t+3<NT),(t+1<NT),(t+1<NT));       ENDW(t);   RESC(); ROT();
    STEP(pA0,pA1,pB0,pB1,t+1,(t+4<NT),(t+2<NT),(t+2<NT));     ENDW(t+1); RESC(); ROT();
  }
  STEP(pB0,pB1,pA0,pA1,NT-1,false,false,false); RESC();
  { float sacc=pB0[0]+pB0[1]; _Pragma("unroll") for(int r=2;r<16;++r)sacc+=pB0[r]; _Pragma("unroll") for(int r=0;r<16;++r)sacc+=pB1[r]; l_reg+=sacc;
    pw0=(u32x4){PKW(pB0,0),PKW(pB0,2),PKW(pB0,4),PKW(pB0,6)};pw1=(u32x4){PKW(pB0,8),PKW(pB0,10),PKW(pB0,12),PKW(pB0,14)};pw2=(u32x4){PKW(pB1,0),PKW(pB1,2),PKW(pB1,4),PKW(pB1,6)};pw3=(u32x4){PKW(pB1,8),PKW(pB1,10),PKW(pB1,12),PKW(pB1,14)};
    SBAR(); pv(o,vb0+sl_cur,PAF(0),PAF(1),PAF(2),PAF(3)); }
  #undef PKW
  #undef PAF
  #undef VFR
  #undef PIN
  #undef MX3
  #undef GAPA
  #undef GAPB
  #undef EX
  #undef VRD
  #undef KRD
  #undef STEP
  #undef ENDW
  __builtin_amdgcn_s_setprio(0);
  {auto rr=__builtin_amdgcn_permlane32_swap(__float_as_uint(l_reg),__float_as_uint(l_reg),false,false);l_reg=__uint_as_float(rr[0])+__uint_as_float(rr[1]);}
  if(hi==0)wsf[32+r32]=l_reg;asm volatile("s_waitcnt lgkmcnt(0)":::"memory");
  float rli[16];
  #pragma unroll
  for(int r=0;r<16;++r)rli[r]=__builtin_amdgcn_rcpf(wsf[32+crow(r,hi)]);
  bf16*Ow=O+(rowbase+q0+wid*QBLK)*OP+h*D;
  { bf16*stg=(bf16*)(shm+LDS_OST)+wid*2048;
    #pragma unroll
    for(int r=0;r<16;++r){const int orow=crow(r,hi);
      #pragma unroll
      for(int d0=0;d0<2;++d0)stg[orow*64+d0*32+r32]=__float2bfloat16(o[d0][r]*rli[r]);}
    asm volatile("s_waitcnt lgkmcnt(0)":::"memory");
    #pragma unroll
    for(int i=0;i<4;++i){const int row=i*8+(lane>>3),ch=lane&7; const u32x4 v=*(const u32x4*)(stg+row*64+ch*8); ATTN_STORE16(Ow+(long)row*OP+ch*8,v);
      float ss=0.f;
      #pragma unroll
      for(int e=0;e<4;++e){const float lo=__uint_as_float(v[e]<<16),hi_=__uint_as_float(v[e]&0xffff0000u); ss+=lo*lo+hi_*hi_;}
      ss+=__shfl_xor(ss,1); ss+=__shfl_xor(ss,2); ss+=__shfl_xor(ss,4);
      if(ch==0)atomicAdd(gssrow+rowbase+q0+wid*QBLK+row,ss);} }
  asm volatile("s_waitcnt lgkmcnt(0)\n\ts_barrier":::"memory");
  #undef DMA_K
  #undef DMA_V
  #undef CMASK
  #undef START
  #undef RESC
  #undef ROT
}
#undef SBAR
#undef WAIT_BAR
}
#define LAS __attribute__((address_space(3)))
typedef unsigned short bf16;
typedef unsigned v4u __attribute__((ext_vector_type(4)));
typedef unsigned v2u __attribute__((ext_vector_type(2)));
typedef float f32x4 __attribute__((ext_vector_type(4)));
typedef float f32x16 __attribute__((ext_vector_type(16)));
typedef short bf16x8 __attribute__((ext_vector_type(8)));
typedef short s16x4 __attribute__((ext_vector_type(4)));
using pg8::pk_bf16;

#define XB_TMO      128
#define XB_XCNT(j)  (256  + 64 * (j))
#define XB_XSUB(j)  (1280 + 64 * (j))
#define XB_XGEN(j)  (2304 + 64 * (j))
#define XB_TOP      3328
#define XB_TOPGEN   3392
#define XCD_BAR_WORDS 3456
#define XB_SPIN_CAP (1u << 18)

__device__ __forceinline__ unsigned xb_ld(unsigned* p)              { return __hip_atomic_load(p, __ATOMIC_RELAXED, __HIP_MEMORY_SCOPE_AGENT); }
__device__ __forceinline__ unsigned xb_add(unsigned* p, unsigned v) { return __hip_atomic_fetch_add(p, v, __ATOMIC_RELAXED, __HIP_MEMORY_SCOPE_AGENT); }
__device__ __forceinline__ unsigned xb_xcc_id() { return (unsigned)__builtin_amdgcn_s_getreg((3 << 11) | 20) & 0xFu; }
#define XB_SPIN(cond, bar) do { unsigned _sp = 0; while (cond) { __builtin_amdgcn_s_sleep(1); \
    if ((++_sp & 255u) == 0u) { if (xb_ld(&(bar)[XB_TMO])) break; if (_sp > XB_SPIN_CAP) { atomicAdd(&(bar)[XB_TMO], 1u); break; } } } } while (0)

struct XcdBarrier {
    unsigned* bar; unsigned x;
    volatile LAS unsigned* st;
};

__device__ __forceinline__ XcdBarrier xcd_barrier_post(unsigned* bar, volatile LAS unsigned* st) {
    XcdBarrier b; b.bar = bar; b.x = xb_xcc_id(); b.st = st;
    if (threadIdx.x == 0) (void)xb_add(&bar[XB_XCNT(b.x)], 1u);
    return b;
}
__device__ __forceinline__ void xcd_barrier_complete(unsigned* bar, unsigned x, unsigned& nloc, unsigned& nx) {
    const unsigned G = gridDim.x * gridDim.y * gridDim.z;
    unsigned sum, cnt, mine, sp = 0u;
    for (;;) {
        sum = 0u; cnt = 0u; mine = 0u;
#pragma unroll
        for (unsigned j = 0; j < 16; ++j) { const unsigned c = xb_ld(&bar[XB_XCNT(j)]); sum += c; cnt += (c > 0u) ? 1u : 0u; mine = (j == x) ? c : mine; }
        if (sum == G) break;
        __builtin_amdgcn_s_sleep(1);
        if ((++sp & 255u) == 0u) { if (xb_ld(&bar[XB_TMO])) break; if (sp > XB_SPIN_CAP) { atomicAdd(&bar[XB_TMO], 1u); break; } }
    }
    nloc = mine > 0u ? mine : 1u; nx = cnt > 0u ? cnt : 1u;
}

__device__ __forceinline__ void xcd_barrier(const XcdBarrier& b) {
    asm volatile("s_waitcnt vmcnt(0)" ::: "memory");
    __syncthreads();
    if (threadIdx.x == 0) {
        unsigned* bar = b.bar;
        __builtin_amdgcn_s_waitcnt(0);
        unsigned nloc = b.st[0], nx = b.st[1];
        if (nloc == 0u) { xcd_barrier_complete(bar, b.x, nloc, nx); b.st[0] = nloc; b.st[1] = nx; }
        const unsigned old = xb_add(&bar[XB_XSUB(b.x)], 1u);
        const unsigned gen = old / nloc;
        if (old + 1u == (gen + 1u) * nloc) {
            __builtin_amdgcn_fence(__ATOMIC_RELEASE, "agent");
            asm volatile("s_waitcnt vmcnt(0)" ::: "memory");
            const unsigned og = xb_add(&bar[XB_TOP], 1u);
            const unsigned tg = og / nx;
            if (og + 1u == (tg + 1u) * nx) xb_add(&bar[XB_TOPGEN], 1u);
            else XB_SPIN(xb_ld(&bar[XB_TOPGEN]) == tg, bar);
            __builtin_amdgcn_fence(__ATOMIC_ACQUIRE, "agent");
            xb_add(&bar[XB_XGEN(b.x)], 1u);
            asm volatile("s_waitcnt vmcnt(0)" ::: "memory");
        } else {
            XB_SPIN(xb_ld(&bar[XB_XGEN(b.x)]) == gen, bar);
            __builtin_amdgcn_fence(__ATOMIC_ACQUIRE, "agent");
            asm volatile("s_waitcnt vmcnt(0)" ::: "memory");
        }
    }
    __syncthreads();
}


constexpr size_t MiB = 1u << 20;
constexpr size_t WS_BAR = 0;
constexpr size_t WS_MOD = 64 * 1024;
constexpr size_t WS_BIASIN = 160 * 1024;
constexpr size_t WS_BIASGU = 192 * 1024;
constexpr size_t WS_ROPEC = 288 * 1024;
constexpr size_t WS_ROPES = 304 * 1024;
constexpr size_t WS_MREF = 328 * 1024;
constexpr size_t WS_KMAX = 332 * 1024;
constexpr size_t WS_ROWSS = 384 * 1024;
constexpr size_t WS_SWB = 320 * 1024;
constexpr size_t WS_WIN = 368 * MiB;
constexpr size_t WS_WO = 9 * MiB;
constexpr size_t WS_WGU = 384 * MiB;
constexpr size_t WS_WDN = 35 * MiB;
constexpr size_t WS_GSS = 46 * MiB;
constexpr size_t WS_H = 48 * MiB;
constexpr size_t WS_QKV = 112 * MiB;
constexpr size_t WS_Y = 240 * MiB;
constexpr size_t WS_ACT = 112 * MiB;
constexpr size_t WS_XA = 304 * MiB;
constexpr size_t WS_END = 428 * MiB;

constexpr int LDS_BYTES = 135168;

__device__ __forceinline__ float wave_sum(float v) {
#pragma unroll
    for (int o = 1; o < 64; o <<= 1) v += __shfl_xor(v, o);
    return v;
}

__device__ __forceinline__ int permf(int i) { return 16 * ((i >> 2) & 1) + 4 * (i >> 3) + (i & 3); }
__device__ __forceinline__ void tr_item(const float* W, int K, int N, int k0, int sc0, bool perm, bf16* WT, int dr0, LAS float* scr, int lane, const float* ksc = nullptr) {
#pragma unroll 8
    for (int i = 0; i < 32; ++i) { const int kk = 2 * i + (lane >> 5); scr[kk * 33 + (lane & 31)] = W[(size_t)(k0 + kk) * N + sc0 + (lane & 31)]; }
    asm volatile("s_waitcnt lgkmcnt(0)" ::: "memory");
    const int c = lane & 7;
    float kq[8];
#pragma unroll
    for (int e = 0; e < 8; ++e) kq[e] = ksc ? ksc[k0 + 8 * c + e] : 1.0f;
#pragma unroll
    for (int j = 0; j < 4; ++j) { const int n = (lane >> 3) + 8 * j; const int ci = perm ? permf(n) : n; const LAS float* s = scr + (8 * c) * 33 + ci;
        v4u o; o.x = pk_bf16(s[0 * 33] * kq[0], s[1 * 33] * kq[1]); o.y = pk_bf16(s[2 * 33] * kq[2], s[3 * 33] * kq[3]); o.z = pk_bf16(s[4 * 33] * kq[4], s[5 * 33] * kq[5]); o.w = pk_bf16(s[6 * 33] * kq[6], s[7 * 33] * kq[7]);
        *(v4u*)(WT + (size_t)(dr0 + n) * K + k0 + 8 * c) = o; }
    asm volatile("s_waitcnt lgkmcnt(0)" ::: "memory");
}
__device__ __forceinline__ void tr_item_ada(const float* W, int K, int N, int k0, int sc0, bool perm, bf16* WT0, bf16* WT1, int dr0, LAS float* scr, int lane,
                                            const float* g, const float* scA, const float* scB, const float* shA, const float* shB, float* biasA, float* biasB) {
#pragma unroll 8
    for (int i = 0; i < 32; ++i) { const int kk = 2 * i + (lane >> 5); scr[kk * 33 + (lane & 31)] = W[(size_t)(k0 + kk) * N + sc0 + (lane & 31)]; }
    asm volatile("s_waitcnt lgkmcnt(0)" ::: "memory");
    const int c = lane & 7;
    float qa[8], qb[8];
#pragma unroll
    for (int e = 0; e < 8; ++e) { const int k = k0 + 8 * c + e; const float gk = g[k]; qa[e] = gk * (1.0f + scA[k]); qb[e] = gk * (1.0f + scB[k]); }
#pragma unroll
    for (int j = 0; j < 4; ++j) { const int n = (lane >> 3) + 8 * j; const int ci = perm ? permf(n) : n; const LAS float* s = scr + (8 * c) * 33 + ci;
        float t[8];
#pragma unroll
        for (int e = 0; e < 8; ++e) t[e] = s[e * 33];
        v4u o; o.x = pg8::pk_f16(t[0] * qa[0], t[1] * qa[1]); o.y = pg8::pk_f16(t[2] * qa[2], t[3] * qa[3]); o.z = pg8::pk_f16(t[4] * qa[4], t[5] * qa[5]); o.w = pg8::pk_f16(t[6] * qa[6], t[7] * qa[7]);
        *(v4u*)(WT0 + (size_t)(dr0 + n) * K + k0 + 8 * c) = o;
        v4u p; p.x = pg8::pk_f16(t[0] * qb[0], t[1] * qb[1]); p.y = pg8::pk_f16(t[2] * qb[2], t[3] * qb[3]); p.z = pg8::pk_f16(t[4] * qb[4], t[5] * qb[5]); p.w = pg8::pk_f16(t[6] * qb[6], t[7] * qb[7]);
        *(v4u*)(WT1 + (size_t)(dr0 + n) * K + k0 + 8 * c) = p; }
    { const int n32 = lane & 31, hf = lane >> 5; const int cb = perm ? permf(n32) : n32;
      float bA = 0.f, bB = 0.f;
#pragma unroll 8
      for (int kk = 0; kk < 32; ++kk) { const int k = hf * 32 + kk; const float w = scr[k * 33 + cb]; bA += shA[k0 + k] * w; bB += shB[k0 + k] * w; }
      bA += __shfl_xor(bA, 32); bB += __shfl_xor(bB, 32);
      if (hf == 0) { atomicAdd(biasA + dr0 + n32, bA); atomicAdd(biasB + dr0 + n32, bB); } }
    asm volatile("s_waitcnt lgkmcnt(0)" ::: "memory");
}
__device__ __forceinline__ void win_src(int n0, int& sc0, bool& perm) {
    const int tile = n0 >> 8, bj = (n0 >> 7) & 1, w = n0 & 127;
    if (tile < 5 || (tile == 5 && bj == 0)) { sc0 = n0; perm = false; }
    else if (tile == 5) { sc0 = 1920 + w; perm = false; }
    else { const int s = w >> 5; const int hb = (tile == 6) ? 1408 + 64 * s : (s < 2 ? 1408 + 64 * (4 + s) : 1792 + 64 * (s - 2)); sc0 = hb + 32 * bj; perm = true; }
}

struct Args { const float* in[17]; float* out; unsigned char* ws; int ph_lo, ph_hi; };
enum { I_X = 0, I_C, I_WMOD, I_BMOD, I_GATTN, I_WIN, I_RPB, I_SINK, I_T5, I_GQ, I_GK, I_GGROUP, I_WO, I_GFFN, I_WGU, I_WDOWN, I_GFINAL };

__device__ __forceinline__ void phase_prep(const Args& a, LAS unsigned char* lds, int tid, int lane, int wave) {
    unsigned char* ws = a.ws;
    const int G = gridDim.x;
    for (int it = blockIdx.x; it < 192; it += G) {
        const int l = it / 96, j0 = (it % 96) * 64;
        const float* W = a.in[I_WMOD] + (size_t)l * 1024 * 6144 + j0 + lane;
        const float* c0 = a.in[I_C]; const float* c1 = c0 + 1024;
        float a0 = 0.f, a1 = 0.f;
        const int kb = wave * 128;
#pragma unroll 32
        for (int k = 0; k < 128; ++k) {
            const float w = W[(size_t)(kb + k) * 6144];
            const float x0 = c0[kb + k], x1 = c1[kb + k];
            a0 += w * (x0 / (1.0f + __expf(-x0))); a1 += w * (x1 / (1.0f + __expf(-x1)));
        }
        LAS float* red = (LAS float*)lds;
        red[(wave * 2 + 0) * 64 + lane] = a0; red[(wave * 2 + 1) * 64 + lane] = a1;
        __syncthreads();
        if (wave < 2) { float s = 0.f;
#pragma unroll
            for (int w8 = 0; w8 < 8; ++w8) s += red[(w8 * 2 + wave) * 64 + lane];
            s += a.in[I_BMOD][l * 6144 + j0 + lane];
            ((float*)(ws + WS_MOD))[(size_t)(l * 2 + wave) * 6144 + j0 + lane] = s; }
        __syncthreads();
    }
    for (int i = blockIdx.x * 512 + tid + MT / 4; i < 5 * MT / 4; i += G * 512) ((f32x4*)(ws + WS_ROWSS))[i] = (f32x4){0.f, 0.f, 0.f, 0.f};
    for (int i = blockIdx.x * 512 + tid; i < 6 * MT / 4; i += G * 512) ((f32x4*)(ws + WS_GSS))[i] = (f32x4){0.f, 0.f, 0.f, 0.f};
    for (int i = blockIdx.x * 512 + tid; i < (120 * 1024) / 16; i += G * 512) ((f32x4*)(ws + WS_BIASIN))[i] = (f32x4){0.f, 0.f, 0.f, 0.f};
    const int gt = blockIdx.x * 512 + tid;
    if (gt < 4096) { const int pos = gt >> 4, f = gt & 15; const float fr = exp2f(-(float)f * (13.287712379549449f / 16.0f)); const float ang = (float)pos * fr;
        ((float*)(ws + WS_ROPEC))[gt] = cosf(ang); ((float*)(ws + WS_ROPES))[gt] = sinf(ang); }
    if (gt >= 4096 && gt < 4096 + 6 * 257) { const int e = gt - 4096, h = e / 257, r = e % 257; const int rel = r - 128; const int n = rel < 0 ? -rel : rel;
        int bk = rel > 0 ? 16 : 0; int lg = n < 8 ? n : 8 + ((31 - __builtin_clz((unsigned)(n * n))) - 6); if (lg > 15) lg = 15; bk += lg;
        ((float*)(ws + WS_SWB))[h * 260 + r] = a.in[I_T5][bk * 6 + h] * LOG2E_; }
    if (gt >= 5900 && gt < 5900 + 32) ((unsigned*)(ws + WS_KMAX))[gt - 5900] = 0u;
    if (gt >= 5800 && gt < 5800 + DEPTH_) { const int l = gt - 5800; float gqm = 0.f, gkm = 0.f;
        for (int i = 0; i < 64; ++i) { gqm = fmaxf(gqm, fabsf(a.in[I_GQ][l * 64 + i])); gkm = fmaxf(gkm, fabsf(a.in[I_GK][l * 64 + i])); }
        ((float*)(ws + WS_MREF))[l] = fminf(8.0f * gqm * gkm * LOG2E_ * 1.02f, 100.0f); }
    { const int gw = blockIdx.x * 8 + wave, NGW = G * 8;
      const float* x = a.in[I_X]; float* rowss = (float*)(ws + WS_ROWSS);
      for (int blk = gw; blk < MT / 16; blk += NGW) {
        const int r0 = blk * 16;
#pragma unroll 2
        for (int r = 0; r < 16; ++r) {
            const f32x4* xr = (const f32x4*)(x + (size_t)(r0 + r) * 1024) + lane;
            f32x4 v[4]; float s_ = 0.f;
#pragma unroll
            for (int j = 0; j < 4; ++j) { v[j] = xr[64 * j]; s_ += (v[j][0] * v[j][0] + v[j][1] * v[j][1]) + (v[j][2] * v[j][2] + v[j][3] * v[j][3]); }
            s_ = wave_sum(s_);
            if (lane == 0) rowss[r0 + r] = s_;
            v2u* x8 = (v2u*)((bf16*)(ws + WS_H) + (size_t)(r0 + r) * 1024) + lane;
#pragma unroll
            for (int j = 0; j < 4; ++j) { v2u wx; wx.x = pg8::pk_f16(v[j][0], v[j][1]); wx.y = pg8::pk_f16(v[j][2], v[j][3]); x8[64 * j] = wx; }
        }
      } }
}

__device__ __forceinline__ void phase_p1(const Args& a, LAS unsigned char* lds, int lane, int wave) {
    unsigned char* ws = a.ws;
    const float* mod = (const float*)(ws + WS_MOD);
    LAS float* scr = (LAS float*)(lds + wave * 16384);
    const int gw = blockIdx.x * 8 + wave, NGW = gridDim.x * 8;
    constexpr int IT_IN = 16 * 64, IT_O = 16 * 32, IT_GU = 16 * 176, IT_DN = 44 * 32, IT_L = IT_IN + IT_O + IT_GU + IT_DN;
    for (int it = gw; it < 2 * IT_L; it += NGW) {
        const int l = it / IT_L; int r = it % IT_L;
        const float* md = mod + (size_t)l * 2 * 6144;
        if (r < IT_IN) { const int kb = r >> 6, nb = r & 63; int sc0; bool perm; win_src(nb * 32, sc0, perm);
            bf16* wt = (bf16*)(ws + WS_WIN) + (size_t)l * 2 * 2048 * 1024;
            tr_item_ada(a.in[I_WIN] + (size_t)l * 1024 * 2048, 1024, 2048, kb * 64, sc0, perm, wt, wt + (size_t)2048 * 1024, nb * 32, scr, lane,
                        a.in[I_GATTN] + l * 1024, md + 1024, md + 6144 + 1024, md, md + 6144, (float*)(ws + WS_BIASIN) + (size_t)l * 2 * 2048, (float*)(ws + WS_BIASIN) + (size_t)l * 2 * 2048 + 2048); continue; }
        r -= IT_IN;
        if (r < IT_O) { const int kb = r >> 5, nb = r & 31;
            tr_item(a.in[I_WO] + (size_t)l * 1024 * 1024, 1024, 1024, kb * 64, nb * 32, false, (bf16*)(ws + WS_WO) + (size_t)l * 1024 * 1024, nb * 32, scr, lane, a.in[I_GGROUP] + l * 1024); continue; }
        r -= IT_O;
        if (r < IT_GU) { const int kb = r / 176, nb = r % 176; const int n0 = nb * 32; const int sc0 = ((n0 >> 7) & 1) * 2816 + (n0 >> 8) * 128 + (n0 & 127);
            bf16* wt = (bf16*)(ws + WS_WGU) + (size_t)l * 2 * 5632 * 1024;
            tr_item_ada(a.in[I_WGU] + (size_t)l * 1024 * 5632, 1024, 5632, kb * 64, sc0, false, wt, wt + (size_t)5632 * 1024, n0, scr, lane,
                        a.in[I_GFFN] + l * 1024, md + 4096, md + 6144 + 4096, md + 3072, md + 6144 + 3072, (float*)(ws + WS_BIASGU) + (size_t)l * 2 * 5632, (float*)(ws + WS_BIASGU) + (size_t)l * 2 * 5632 + 5632); continue; }
        r -= IT_GU;
        { const int kb = r >> 5, nb = r & 31;
            tr_item(a.in[I_WDOWN] + (size_t)l * 2816 * 1024, 2816, 1024, kb * 64, nb * 32, false, (bf16*)(ws + WS_WDN) + (size_t)l * 1024 * 2816, nb * 32, scr, lane); }
    }
}
__device__ __forceinline__ void phase_final(const bf16* xb, float* out, const float* g, const float* rowss, int lane, int wave) {
    const int gw = blockIdx.x * 8 + wave, NGW = gridDim.x * 8;
    f32x4 gv[4];
#pragma unroll
    for (int j = 0; j < 4; ++j) gv[j] = *(const f32x4*)(g + 16 * lane + 4 * j);
    for (int row = gw; row < MT; row += NGW) {
        const v4u* xr = (const v4u*)(xb + (size_t)row * 1024 + 16 * lane);
        const v4u w0 = xr[0], w1 = xr[1];
        const float rinv = rsqrtf(rowss[row] * (1.0f / 1024.0f) + EPS_);
        f32x4* o = (f32x4*)(out + (size_t)row * 1024 + 16 * lane);
        { const pg8::f32x2 a0 = pg8::up_f16(w0.x), a1 = pg8::up_f16(w0.y), a2 = pg8::up_f16(w0.z), a3 = pg8::up_f16(w0.w);
          const pg8::f32x2 b0 = pg8::up_f16(w1.x), b1 = pg8::up_f16(w1.y), b2 = pg8::up_f16(w1.z), b3 = pg8::up_f16(w1.w);
          o[0] = (f32x4){a0[0], a0[1], a1[0], a1[1]} * rinv * gv[0]; o[1] = (f32x4){a2[0], a2[1], a3[0], a3[1]} * rinv * gv[1];
          o[2] = (f32x4){b0[0], b0[1], b1[0], b1[1]} * rinv * gv[2]; o[3] = (f32x4){b2[0], b2[1], b3[0], b3[1]} * rinv * gv[3]; }
    }
}
__device__ __forceinline__ float bf_lo(unsigned w) { return __uint_as_float(w << 16); }
__device__ __forceinline__ float bf_hi(unsigned w) { return __uint_as_float(w & 0xffff0000u); }
__device__ __forceinline__ void phase_gnorm(const bf16* y, const float* gg, bf16* yn, int lane, int wave) {
    const int gw = blockIdx.x * 8 + wave, NGW = gridDim.x * 8;
    float gv[16];
#pragma unroll
    for (int j = 0; j < 4; ++j) { const f32x4 t = *(const f32x4*)(gg + 16 * lane + 4 * j); gv[4 * j] = t[0]; gv[4 * j + 1] = t[1]; gv[4 * j + 2] = t[2]; gv[4 * j + 3] = t[3]; }
    const int grp = lane < 16 ? 0 : (lane < 40 ? 1 : 2);
    for (int row = gw; row < MT; row += NGW) {
        const v4u* yr = (const v4u*)(y + (size_t)row * 1024 + 16 * lane);
        const v4u w0 = yr[0], w1 = yr[1];
        float v[16];
        v[0] = bf_lo(w0.x); v[1] = bf_hi(w0.x); v[2] = bf_lo(w0.y); v[3] = bf_hi(w0.y); v[4] = bf_lo(w0.z); v[5] = bf_hi(w0.z); v[6] = bf_lo(w0.w); v[7] = bf_hi(w0.w);
        v[8] = bf_lo(w1.x); v[9] = bf_hi(w1.x); v[10] = bf_lo(w1.y); v[11] = bf_hi(w1.y); v[12] = bf_lo(w1.z); v[13] = bf_hi(w1.z); v[14] = bf_lo(w1.w); v[15] = bf_hi(w1.w);
        float s = 0.f;
#pragma unroll
        for (int j = 0; j < 16; ++j) s += v[j] * v[j];
        const float sA = wave_sum(grp == 0 ? s : 0.f), sB = wave_sum(grp == 1 ? s : 0.f), sC = wave_sum(grp == 2 ? s : 0.f);
        const float rinv = grp == 0 ? rsqrtf(sA * (1.0f / 256.0f) + EPS_) : (grp == 1 ? rsqrtf(sB * (1.0f / 384.0f) + EPS_) : rsqrtf(sC * (1.0f / 384.0f) + EPS_));
        v4u o0, o1;
        o0.x = pk_bf16(v[0] * rinv * gv[0], v[1] * rinv * gv[1]); o0.y = pk_bf16(v[2] * rinv * gv[2], v[3] * rinv * gv[3]);
        o0.z = pk_bf16(v[4] * rinv * gv[4], v[5] * rinv * gv[5]); o0.w = pk_bf16(v[6] * rinv * gv[6], v[7] * rinv * gv[7]);
        o1.x = pk_bf16(v[8] * rinv * gv[8], v[9] * rinv * gv[9]); o1.y = pk_bf16(v[10] * rinv * gv[10], v[11] * rinv * gv[11]);
        o1.z = pk_bf16(v[12] * rinv * gv[12], v[13] * rinv * gv[13]); o1.w = pk_bf16(v[14] * rinv * gv[14], v[15] * rinv * gv[15]);
        v4u* orow = (v4u*)(yn + (size_t)row * 1024 + 16 * lane);
        orow[0] = o0; orow[1] = o1;
    }
}

__device__ __forceinline__ int crow16(int i, int hi) { return (i & 3) + 8 * (i >> 2) + 4 * hi; }
template <int MODE>
__device__ __forceinline__ void small_attn_wave(const bf16* Qb, int qpitch, const bf16* Kp, const bf16* Vp, int kvpitch, bf16* Ob,
                                                int qt  , int qcol0, const float* gtab, int ntab, float tabscale, float sink2,
                                                float* gssrow, const unsigned* kmax2, LAS unsigned char* wl, int lane) {
    const int r32 = lane & 31, hi = lane >> 5;
    LAS float* tab = (LAS float*)(wl + 9216);
    const int qrow = qt + (r32 >> 4), qc = qcol0 + (r32 & 15);
    const int qtok = MODE == 0 ? qt + r32 : qrow * 64 + qc;
    bf16x8 qf[4];
#pragma unroll
    for (int ks = 0; ks < 4; ++ks) qf[ks] = *(const bf16x8*)(Qb + (size_t)qtok * qpitch + 16 * ks + 8 * hi);
    int nt, tb0, tstep, rsA = 0, kc0 = 0, my_rs = 0, my_cs = 0;
    if (MODE == 0) { const int t0 = qt - 128 < 0 ? 0 : qt - 128; const int t1 = qt + 160 > SEQ_ ? SEQ_ : qt + 160; tb0 = t0; nt = (t1 - t0) >> 5; tstep = 32; }
    else { rsA = qt - 4; rsA = rsA < 0 ? 0 : (rsA > 248 ? 248 : rsA); int rsB = qt - 3; rsB = rsB < 0 ? 0 : (rsB > 248 ? 248 : rsB); nt = 8 + (rsB - rsA);
        kc0 = qcol0 - 8; kc0 = kc0 < 0 ? 0 : (kc0 > 32 ? 32 : kc0); tb0 = rsA * 64 + kc0; tstep = 64;
        my_rs = qrow - 4; my_rs = my_rs < 0 ? 0 : (my_rs > 248 ? 248 : my_rs); my_cs = qc - 8; my_cs = my_cs < 0 ? 0 : (my_cs > 48 ? 48 : my_cs); }
    bf16x8 kf[4]; v4u vr[4];
#define SA_LOAD(tbase) do { const bf16* kp_ = Kp + (size_t)((tbase) + r32) * kvpitch + 8 * hi; \
        _Pragma("unroll") for (int ks = 0; ks < 4; ++ks) kf[ks] = *(const bf16x8*)(kp_ + 16 * ks); \
        _Pragma("unroll") for (int e = 0; e < 4; ++e) { const int c = lane + 64 * e; vr[e] = *(const v4u*)(Vp + (size_t)((tbase) + (c >> 3)) * kvpitch + (c & 7) * 8); } } while (0)
#define SA_VWRITE(buf) do { _Pragma("unroll") for (int e = 0; e < 4; ++e) { const int c = lane + 64 * e; *(LAS v4u*)(wl + (buf) * 4608 + (c >> 3) * 144 + (c & 7) * 16) = vr[e]; } } while (0)
#define SA_QK(X) do { _Pragma("unroll") for (int ks = 0; ks < 4; ++ks) X = __builtin_amdgcn_mfma_f32_32x32x16_bf16(kf[ks], qf[ks], X, 0, 0, 0); } while (0)
#define SA_CINIT(ti, X) do { const int tbc = tb0 + tstep * (ti); \
        if (MODE == 0) { const int relb = tbc - qtok + 4 * hi; const int d = tbc - qt; \
            if (d >= -96 && d <= 96) { const LAS float* tp = tab + (relb + 128); \
                _Pragma("unroll") for (int e = 0; e < 16; ++e) X[e] = tp[(e & 3) + 8 * (e >> 2)]; \
            } else { \
                _Pragma("unroll") for (int e = 0; e < 16; ++e) { const int rel = relb + (e & 3) + 8 * (e >> 2); const bool ok = (unsigned)(rel + 128) <= 256u; \
                    const int idx = ok ? rel + 128 : 0; X[e] = ok ? tab[idx] : -1e30f; } } \
        } else { \
            const int kr = rsA + (ti); const bool rowok = (unsigned)(kr - my_rs) < 8u; const int colb = kc0 + 4 * hi - my_cs; \
            int ib = (kr - qrow + 7) * 31 + kc0 + 4 * hi - qc + 15; ib = rowok ? ib : 0; \
            _Pragma("unroll") for (int e = 0; e < 16; ++e) { const int cc = (e & 3) + 8 * (e >> 2); const bool ok = rowok && ((unsigned)(colb + cc) < 16u); \
                const int idx = ok ? ib + cc : 0; X[e] = ok ? tab[idx] : -1e30f; } \
        } } while (0)
    SA_LOAD(tb0);
    float bmx = -1e30f;
    for (int e = lane; e < ntab; e += 64) { const float tv_ = gtab[e] * tabscale; tab[e] = tv_; bmx = fmaxf(bmx, tv_); }
#pragma unroll
    for (int o_ = 1; o_ < 64; o_ <<= 1) bmx = fmaxf(bmx, __shfl_xor(bmx, o_));
    float ref;
    { float qs = 0.f;
#pragma unroll
      for (int ks = 0; ks < 4; ++ks) { const v4u qw = __builtin_bit_cast(v4u, qf[ks]);
#pragma unroll
          for (int e = 0; e < 4; ++e) { const float lo_ = __uint_as_float(qw[e] << 16), hi_ = __uint_as_float(qw[e] & 0xffff0000u); qs += lo_ * lo_ + hi_ * hi_; } }
      auto rr = __builtin_amdgcn_permlane32_swap(__float_as_uint(qs), __float_as_uint(qs), false, false); qs = __uint_as_float(rr[0]) + __uint_as_float(rr[1]);
      const float k2 = __uint_as_float(kmax2[0]) + __uint_as_float(kmax2[1]);
      ref = fminf(__builtin_sqrtf(qs * k2) * 1.03f + bmx, 110.0f); }
    f32x16 o0 = {}, o1 = {};
    float lsum = 0.f;
    const int i16 = lane & 15, g16 = (lane >> 4) & 1;
    LAS unsigned char* vaddr = wl + (4 * hi + (i16 >> 2)) * 144 + g16 * 32 + 8 * (i16 & 3);
    f32x16 xa_, xb_;
    SA_VWRITE(0); SA_CINIT(0, xa_); SA_QK(xa_);
    if (nt > 1) SA_LOAD(tb0 + tstep);
#define SA_TILE(i, X, XN) do { \
        const int tb = tb0 + tstep * (i); \
        if ((i) + 1 < nt) { SA_VWRITE(((i) + 1) & 1); SA_CINIT((i) + 1, XN); SA_QK(XN); if ((i) + 2 < nt) SA_LOAD(tb + 2 * tstep); } \
        float ps = 0.f; \
        _Pragma("unroll") for (int e = 0; e < 16; ++e) { const float p_ = __builtin_amdgcn_exp2f(X[e] - ref); X[e] = p_; ps += p_; } \
        lsum += ps; \
        v4u pw0, pw1; \
        pw0.x = pk_bf16(X[0], X[1]); pw0.y = pk_bf16(X[2], X[3]); pw0.z = pk_bf16(X[4], X[5]); pw0.w = pk_bf16(X[6], X[7]); \
        pw1.x = pk_bf16(X[8], X[9]); pw1.y = pk_bf16(X[10], X[11]); pw1.z = pk_bf16(X[12], X[13]); pw1.w = pk_bf16(X[14], X[15]); \
        const bf16x8 pb0 = __builtin_bit_cast(bf16x8, pw0), pb1 = __builtin_bit_cast(bf16x8, pw1); \
        asm volatile("s_waitcnt lgkmcnt(0)" ::: "memory"); \
        LAS unsigned char* va_ = vaddr + ((i) & 1) * 4608; \
        { const s16x4 a0 = TRR(va_, 0), a1 = TRR(va_, 8 * 144), b0 = TRR(va_, 16 * 144), b1 = TRR(va_, 24 * 144); \
          o0 = __builtin_amdgcn_mfma_f32_32x32x16_bf16(CAT(a0, a1), pb0, o0, 0, 0, 0); \
          o0 = __builtin_amdgcn_mfma_f32_32x32x16_bf16(CAT(b0, b1), pb1, o0, 0, 0, 0); } \
        { const s16x4 a0 = TRR(va_, 64), a1 = TRR(va_, 64 + 8 * 144), b0 = TRR(va_, 64 + 16 * 144), b1 = TRR(va_, 64 + 24 * 144); \
          o1 = __builtin_amdgcn_mfma_f32_32x32x16_bf16(CAT(a0, a1), pb0, o1, 0, 0, 0); \
          o1 = __builtin_amdgcn_mfma_f32_32x32x16_bf16(CAT(b0, b1), pb1, o1, 0, 0, 0); } \
        asm volatile("s_waitcnt lgkmcnt(0)" ::: "memory"); \
    } while (0)
    typedef short v4i16_t __attribute__((ext_vector_type(4)));
#define TRR(base, off) __builtin_bit_cast(s16x4, __builtin_amdgcn_ds_read_tr16_b64_v4i16((LAS v4i16_t*)((base) + (off))))
#define CAT(a, b) (bf16x8){a[0], a[1], a[2], a[3], b[0], b[1], b[2], b[3]}
    for (int i = 0; i < nt; i += 2) {
        SA_TILE(i, xa_, xb_);
        if (i + 1 < nt) SA_TILE(i + 1, xb_, xa_);
    }
#undef TRR
#undef CAT
#undef SA_TILE
#undef SA_QK
#undef SA_CINIT
#undef SA_VWRITE
#undef SA_LOAD
    { auto rr = __builtin_amdgcn_permlane32_swap(__float_as_uint(lsum), __float_as_uint(lsum), false, false); lsum = __uint_as_float(rr[0]) + __uint_as_float(rr[1]); }
    if (MODE == 0) lsum += __builtin_amdgcn_exp2f(sink2 - ref);
    const float inv = 1.0f / lsum;
    { float ss = 0.f;
#pragma unroll
      for (int e = 0; e < 16; ++e) { const float a0 = o0[e] * inv, a1 = o1[e] * inv; ss += a0 * a0 + a1 * a1; }
      auto rr = __builtin_amdgcn_permlane32_swap(__float_as_uint(ss), __float_as_uint(ss), false, false); ss = __uint_as_float(rr[0]) + __uint_as_float(rr[1]);
      if (hi == 0) atomicAdd(gssrow + qtok, ss); }
    bf16* orow = Ob + (size_t)qtok * 1024 + 4 * hi;
#pragma unroll
    for (int gq = 0; gq < 4; ++gq) {
        v2u w; w.x = pk_bf16(o0[4 * gq] * inv, o0[4 * gq + 1] * inv); w.y = pk_bf16(o0[4 * gq + 2] * inv, o0[4 * gq + 3] * inv); *(v2u*)(orow + 8 * gq) = w;
        v2u w2; w2.x = pk_bf16(o1[4 * gq] * inv, o1[4 * gq + 1] * inv); w2.y = pk_bf16(o1[4 * gq + 2] * inv, o1[4 * gq + 3] * inv); *(v2u*)(orow + 32 + 8 * gq) = w2;
    }
}

#ifndef PROBE_SYNC
#define PROBE_SYNC 0
#endif
#ifndef PROBE_MISC
#define PROBE_MISC 0
#endif
#ifndef PROBE_GU
#define PROBE_GU 0
#endif
#ifndef PROBE_DENSE
#define PROBE_DENSE 1
#endif
#ifndef PROBE_SMALL
#define PROBE_SMALL 1
#endif
__global__ void __launch_bounds__(512) mega_fwd(Args args) {
    extern __shared__ __attribute__((aligned(16))) unsigned char lds_raw[];
    LAS unsigned char* lds = (LAS unsigned char*)lds_raw;
    cg::grid_group grid = cg::this_grid();
    volatile LAS unsigned* MISC = (volatile LAS unsigned*)(lds + 131072);
    if (threadIdx.x < 16) MISC[threadIdx.x] = 0u;
    __syncthreads();
    XcdBarrier xbar = xcd_barrier_post((unsigned*)(args.ws + WS_BAR), MISC + 8);
#define FRESH() int t_ = threadIdx.x; asm volatile("" : "+v"(t_)); const int tid = t_, lane = t_ & 63, wave = __builtin_amdgcn_readfirstlane(t_ >> 6); (void)tid; (void)lane; (void)wave
    const int G = gridDim.x;
    unsigned char* ws = args.ws;
    const int lo = args.ph_lo, hi = args.ph_hi;
    float* xres = args.out;
    const float* modp = (const float*)(ws + WS_MOD);
    bf16* HB = (bf16*)(ws + WS_H);     bf16* QKV = (bf16*)(ws + WS_QKV); bf16* YB = (bf16*)(ws + WS_Y); bf16* ACT = (bf16*)(ws + WS_ACT);
    int ph = 0;
#define IN_(k) (lo <= (k) && (k) < hi)
#define SEAM(k) do { if (IN_(k) && IN_((k) + 1)) { if (args.ph_lo < 0) grid.sync();   xcd_barrier(xbar); for (int e_ = 0; e_ < PROBE_SYNC; ++e_) xcd_barrier(xbar); } } while (0)

    if (IN_(ph)) { FRESH(); phase_prep(args, lds, tid, lane, wave);
#if PROBE_MISC
        __syncthreads(); phase_prep(args, lds, tid, lane, wave);
#endif
    }
    SEAM(ph); ++ph;
    if (IN_(ph)) { FRESH(); phase_p1(args, lds, lane, wave);
#if PROBE_MISC
        phase_p1(args, lds, lane, wave);
#endif
    }
    SEAM(ph); ++ph;
    float* ROWSS = (float*)(ws + WS_ROWSS); float* GSS = (float*)(ws + WS_GSS);

    for (int l = 0; l < DEPTH_; ++l) {
        const float* mod_l = modp + (size_t)l * 2 * 6144;
        const float* xin = (l == 0) ? args.in[I_X] : xres;
        if (IN_(ph)) {
            pg8::Gemm g{HB, (const bf16*)(ws + WS_WIN) + (size_t)l * 2 * 2048 * 1024, MT, INW, 1024, (size_t)2048 * 1024 * 2, 64};     pg8::StaticOrder S; S.init(MT, INW, G, (int)blockIdx.x, 1);
            pg8::EpiInProj E{QKV, (const float*)(ws + WS_ROPEC), (const float*)(ws + WS_ROPES), args.in[I_GQ] + l * 64, args.in[I_GK] + l * 64, ROWSS + (size_t)(2 * l) * MT, (const float*)(ws + WS_BIASIN) + (size_t)l * 2 * 2048, (unsigned*)(ws + WS_KMAX) + (size_t)l * 16};
            pg8::gemm_phase<pg8::EpiInProj, pg8::StaticOrder, true, true, true>(lds, g, S, E);
        }
        SEAM(ph); ++ph;
        if (IN_(ph)) {
            for (int rep = 0; rep < PROBE_DENSE; ++rep)
            for (int ui = 0, u = blockIdx.x; u < 768; u += G, ++ui) {
                int qb = u & 63, h3 = (u >> 6) % 3, kvh = (u / 192) & 1, b = u / 384;
                if (G == 256) { const int xcd = blockIdx.x & 7, j = blockIdx.x >> 3;
                    b = (xcd >> 1) & 1; kvh = xcd & 1; h3 = ui; qb = (xcd >> 2) * 32 + j; }
                attn_body::attn_unit<8>(b, kvh * 3 + h3, qb, (const attn_body::bf16*)(QKV + pg8::OFF_QC), (const attn_body::bf16*)(QKV + pg8::OFF_KC),
                                        (const attn_body::bf16*)(QKV + pg8::OFF_VC), (attn_body::bf16*)(YB + 640), GSS + (size_t)(l * 3 + 2) * MT, ((const float*)(ws + WS_MREF))[l], (char*)lds_raw);
            }
            __syncthreads();
            FRESH();
            LAS unsigned char* wl = lds + wave * 11264;
            for (int uu = blockIdx.x; uu < 768 * PROBE_SMALL; uu += G) {
                const int u = uu % 768; const int qb = u & 63, h = (u >> 6) % 6, b = u / 384; const int qt = qb * 256 + wave * 32; const size_t rb = (size_t)b * SEQ_;
                small_attn_wave<0>(QKV + pg8::OFF_QB + rb * 384 + h * 64, 384, QKV + pg8::OFF_KB + rb * 128 + (h / 3) * 64, QKV + pg8::OFF_VB + rb * 128 + (h / 3) * 64, 128,
                                   YB + rb * 1024 + 256 + h * 64, qt, 0, (const float*)(ws + WS_SWB) + h * 260, 257, 1.0f, args.in[I_SINK][l * 6 + h] * LOG2E_, GSS + (size_t)(l * 3 + 1) * MT + rb, (const unsigned*)(ws + WS_KMAX) + ((l * 2 + 1) * 4 + h / 3) * 2, wl, lane);
            }
            for (int uu = blockIdx.x; uu < 512 * PROBE_SMALL; uu += G) {
                const int u = uu & 511; const int qb = u & 63, h = (u >> 6) & 3, b = u >> 8; const size_t rb = (size_t)b * SEQ_;
                small_attn_wave<1>(QKV + pg8::OFF_QA + rb * 256 + h * 64, 256, QKV + pg8::OFF_KA + rb * 256 + h * 64, QKV + pg8::OFF_VA + rb * 256 + h * 64, 256,
                                   YB + rb * 1024 + h * 64, qb * 4 + 2 * (wave >> 2), 16 * (wave & 3), args.in[I_RPB] + (size_t)(l * 4 + h) * 465, 465, LOG2E_, 0.f, GSS + (size_t)(l * 3 + 0) * MT + rb, (const unsigned*)(ws + WS_KMAX) + ((l * 2 + 0) * 4 + h) * 2, wl, lane);
            }
            __syncthreads();
        }
        SEAM(ph); ++ph;
        if (IN_(ph)) {
            pg8::Gemm g{YB, (const bf16*)(ws + WS_WO) + (size_t)l * 1024 * 1024, MT, 1024, 1024, 0, 1 << 30}; pg8::StaticOrder S; S.init(MT, 1024, G, (int)blockIdx.x);
            pg8::EpiResid<true> E{HB, HB, mod_l + 2048, 6144, ROWSS + (size_t)(2 * l + 1) * MT, GSS + (size_t)(l * 3) * MT};
            pg8::gemm_phase<pg8::EpiResid<true>, pg8::StaticOrder, true, true>(lds, g, S, E);
        }
        SEAM(ph); ++ph;
        if (IN_(ph)) {
            pg8::Gemm g{HB, (const bf16*)(ws + WS_WGU) + (size_t)l * 2 * 5632 * 1024, MT, 5632, 1024, (size_t)5632 * 1024 * 2, 64}; pg8::StaticOrder S; S.init(MT, 5632, G, (int)blockIdx.x);
            pg8::EpiSwiGLU E{ACT, ROWSS + (size_t)(2 * l + 1) * MT, (const float*)(ws + WS_BIASGU) + (size_t)l * 2 * 5632};
            pg8::gemm_phase<pg8::EpiSwiGLU, pg8::StaticOrder, true, true, true>(lds, g, S, E);
#if PROBE_GU
            pg8::gemm_phase<pg8::EpiSwiGLU, pg8::StaticOrder, true, true, true>(lds, g, S, E);
#endif
        }
        SEAM(ph); ++ph;
        if (IN_(ph)) {
            pg8::Gemm g{ACT, (const bf16*)(ws + WS_WDN) + (size_t)l * 1024 * 2816, MT, 1024, 2816, 0, 1 << 30}; pg8::StaticOrder S; S.init(MT, 1024, G, (int)blockIdx.x);
            pg8::EpiResid<false> E{HB, HB, mod_l + 5120, 6144, ROWSS + (size_t)(2 * l + 2) * MT, nullptr};
            pg8::gemm_phase<pg8::EpiResid<false>, pg8::StaticOrder, true, true>(lds, g, S, E);
        }
        SEAM(ph); ++ph;
    }
    if (IN_(ph)) { FRESH(); phase_final(HB, xres, args.in[I_GFINAL], ROWSS + (size_t)(2 * DEPTH_) * MT, lane, wave); }
#undef IN_
#undef SEAM
}

constexpr int N_PHASES = 2 + 5 * DEPTH_ + 1;
#ifndef MK_PER_PHASE
#define MK_PER_PHASE 0
#endif

extern "C" void kernel_launch(void* const* d_in, const int* in_sizes, int n_in, void* d_out, int out_size, void* d_ws, size_t ws_size, hipStream_t stream) {
    static int grid = 0;
    if (grid == 0) {
        if (n_in != 17 || out_size != MT * DM || ws_size < WS_END) { fprintf(stderr, "kernel_launch: unexpected shapes (n_in %d out %d ws %zu)\n", n_in, out_size, ws_size); grid = -1; return; }
        int dev = 0, cus = 0, per_cu = 0;
        hipGetDevice(&dev); hipDeviceGetAttribute(&cus, hipDeviceAttributeMultiprocessorCount, dev);
        if (hipFuncSetAttribute((const void*)mega_fwd, hipFuncAttributeMaxDynamicSharedMemorySize, LDS_BYTES) != hipSuccess) { fprintf(stderr, "kernel_launch: hipFuncSetAttribute failed\n"); grid = -1; return; }
        if (hipOccupancyMaxActiveBlocksPerMultiprocessor(&per_cu, (const void*)mega_fwd, 512, LDS_BYTES) != hipSuccess || per_cu < 1) { fprintf(stderr, "kernel_launch: occupancy query says %d\n", per_cu); per_cu = 1; }
        (void)hipGetLastError();
        grid = cus * 1;
        fprintf(stderr, "kernel_launch: grid %d (cus %d, per_cu %d)\n", grid, cus, per_cu);
    }
    if (grid < 0) return;
    if (hipMemsetAsync((char*)d_ws + WS_BAR, 0, 16384, stream) != hipSuccess) { fprintf(stderr, "kernel_launch: memset failed\n"); return; }
    Args a{};
    for (int i = 0; i < 17; ++i) a.in[i] = (const float*)d_in[i];
    a.out = (float*)d_out; a.ws = (unsigned char*)d_ws;
#if MK_PER_PHASE
    for (int p = 0; p < N_PHASES; ++p) { a.ph_lo = p; a.ph_hi = p + 1; hipLaunchKernelGGL(mega_fwd, dim3(grid), dim3(512), LDS_BYTES, stream, a); }
#else
    a.ph_lo = 0; a.ph_hi = N_PHASES;
    void* kargs[] = {&a};
    hipError_t e = hipLaunchCooperativeKernel((const void*)mega_fwd, dim3(grid), dim3(512), kargs, LDS_BYTES, stream);
    if (e != hipSuccess) fprintf(stderr, "kernel_launch: cooperative launch failed: %s (grid %d)\n", hipGetErrorString(e), grid);
#endif
}
```

```cpp
#include <hip/hip_runtime.h>
#include <hip/hip_bf16.h>
#include <hip/hip_cooperative_groups.h>
#include <cstdio>
#include <cstdint>
#include <cmath>
namespace cg = cooperative_groups;

constexpr int DM = 1024, NB = 2, SEQ_ = 16384, MT = NB * SEQ_, DEPTH_ = 2, FFH = 2816, INW = 2048;
constexpr float EPS_ = 1e-6f;
constexpr float LOG2E_ = 1.4426950408889634f;

#ifndef PROBE_EPI
#define PROBE_EPI 0
#endif
namespace pg8 {
#define PG8_LAS __attribute__((address_space(3)))
typedef unsigned short bf16_t;
typedef short bf16x8 __attribute__((ext_vector_type(8)));
typedef float f32x4 __attribute__((ext_vector_type(4)));
typedef unsigned u32x4 __attribute__((ext_vector_type(4)));
constexpr int BM = 256, BK = 64, HALF = 128, HTB = HALF * BK * 2  , STAGE_BYTES = 8 * HTB, NXCD = 8, WGM = 4;

__host__ __device__ __forceinline__ int lds_byte(int r, int c) { const int st = (r >> 4) * 2 + (c >> 5), rr = r & 15, cc = c & 31, ob = rr * 64 + cc * 2; return st * 1024 + (ob ^ (((ob >> 9) & 1) << 5)); }
__host__ __device__ __forceinline__ void stage_rc(int b, int& R, int& C) { const int st = b / 1024, sb = b % 1024, swz = sb ^ (((sb >> 9) & 1) << 5); R = (st >> 1) * 16 + swz / 64; C = (st & 1) * 32 + (swz % 64) / 2; }
__host__ __device__ __forceinline__ int perm32(int rho) { const int n = rho >> 4, i = rho & 15; return 8 * (i >> 2) + 4 * n + (i & 3); }

struct Unit { int pm, pn; };
struct Gemm { const bf16_t* A; const bf16_t* Bt; int M, N, K; size_t bstride; int mhalf; };

struct StaticOrder {
    int nM, nN, nwg, G, c, swz;
    __host__ __device__ void init(int M, int N, int G_, int c_, int swz_ = 0) { nM = M / BM; nN = N / BM; nwg = nM * nN; G = G_; c = c_; swz = swz_; }
    __host__ __device__ bool next(int i, Unit& u) const {
        const long L = (long)i * G + c; if (L >= nwg) return false;
        int wgid = (int)L; { const int q = nwg / NXCD, r = nwg % NXCD, xcd = wgid % NXCD, off = wgid / NXCD; wgid = (xcd < r ? xcd * (q + 1) : r * (q + 1) + (xcd - r) * q) + off; }
        const int nig = WGM * nN, gid = wgid / nig, fm = gid * WGM, gsz = (nM - fm) < WGM ? (nM - fm) : WGM;
        u.pm = fm + ((wgid % nig) % gsz); u.pn = (wgid % nig) / gsz; if (swz && u.pn >= 4) u.pn ^= ((u.pm >> 3) & 1) << 1; return true;
    }
    __device__ __forceinline__ void a_ready(const Unit&) const {}
    __device__ __forceinline__ void done(const Unit&) const {}
};

__device__ __forceinline__ unsigned cvt_pk_bf16(float lo, float hi) { unsigned r; asm volatile("v_cvt_pk_bf16_f32 %0, %1, %2" : "=v"(r) : "v"(lo), "v"(hi)); return r; }
typedef float f32x2 __attribute__((ext_vector_type(2)));

typedef __bf16 bf16x2_t __attribute__((ext_vector_type(2)));
__device__ __forceinline__ unsigned pk_bf16(float lo, float hi) { f32x2 v = {lo, hi}; bf16x2_t b = __builtin_convertvector(v, bf16x2_t); return __builtin_bit_cast(unsigned, b); }

typedef _Float16 f16x2_t __attribute__((ext_vector_type(2)));
__device__ __forceinline__ unsigned pk_f16(float lo, float hi) { f32x2 v = {lo, hi}; f16x2_t h = __builtin_convertvector(v, f16x2_t); return __builtin_bit_cast(unsigned, h); }
__device__ __forceinline__ f32x2 up_f16(unsigned w) { return __builtin_convertvector(__builtin_bit_cast(f16x2_t, w), f32x2); }
constexpr size_t QM = 32768;
constexpr size_t OFF_QA = 0, OFF_KA = QM * 256, OFF_VA = 2 * QM * 256, OFF_QB = 3 * QM * 256, OFF_KB = OFF_QB + QM * 384, OFF_VB = OFF_KB + QM * 128,
                 OFF_QC = OFF_VB + QM * 128, OFF_KC = OFF_QC + QM * 384, OFF_VC = OFF_KC + QM * 128;

struct EpiInProj {
    static constexpr bool PERM = true, AFTER_DRAIN = false, PROBE2 = false, KHOOK = false;
    bf16_t* qkv; const float* ropec; const float* ropes; const float* gq; const float* gk; const float* rowss; const float* bias; unsigned* kmax;
    __device__ __forceinline__ void operator()(const f32x4 (&acc)[2][2][4][2], const Unit& u, int wr, int wc, int fr, int fq) const {
        const int row0 = u.pm * BM + wr * 64 + fr; const int pn = u.pn;
        int fqo = fq; asm volatile("" : "+v"(fqo));
        const float* bp = bias + (size_t)((u.pm * BM) >> 14) * 2048 + pn * BM + wc * 32 + 8 * fqo;
        if (pn < 6) {
#pragma unroll
            for (int bj = 0; bj < 2; ++bj) {
                size_t off; int pitch, c0;
                if (pn < 3) { off = (size_t)pn * QM * 256; pitch = 256; c0 = bj * 128; }
                else if (pn == 3) { off = OFF_QB; pitch = 384; c0 = bj * 128; }
                else if (pn == 4) { if (bj == 0) { off = OFF_QB; pitch = 384; c0 = 256; } else { off = OFF_KB; pitch = 128; c0 = 0; } }
                else { off = bj == 0 ? OFF_VB : OFF_VC; pitch = 128; c0 = 0; }
                bf16_t* base = qkv + off + c0 + wc * 32 + 8 * fqo;
                const f32x4 bz0 = *(const f32x4*)(bp + bj * HALF), bz1 = *(const f32x4*)(bp + bj * HALF + 4);
                const float qsc = (pn == 0 || pn == 3 || (pn == 4 && bj == 0)) ? 0.125f * 1.4426950408889634f : 1.0f;
                const bool isk = (pn == 1) || (pn == 4 && bj == 1);
                float kmx = 0.f;
#pragma unroll
                for (int ai = 0; ai < 2; ++ai)
#pragma unroll
                    for (int m = 0; m < 4; ++m) {
                        const int row = row0 + ai * HALF + m * 16;
                        const float rv = rsqrtf(rowss[row] * (1.0f / 1024.0f) + 1e-6f);
                        const f32x4 v0 = (acc[ai][bj][m][0] * rv + bz0) * qsc, v1 = (acc[ai][bj][m][1] * rv + bz1) * qsc;
                        if (isk) { float s2 = (v0[0] * v0[0] + v0[1] * v0[1]) + (v0[2] * v0[2] + v0[3] * v0[3]) + (v1[0] * v1[0] + v1[1] * v1[1]) + (v1[2] * v1[2] + v1[3] * v1[3]);
                            s2 += __shfl_xor(s2, 16); s2 += __shfl_xor(s2, 32); kmx = fmaxf(kmx, s2); }
                        u32x4 w; w.x = pk_bf16(v0[0], v0[1]); w.y = pk_bf16(v0[2], v0[3]); w.z = pk_bf16(v1[0], v1[1]); w.w = pk_bf16(v1[2], v1[3]);
                        *(u32x4*)(base + (size_t)row * pitch) = w;
                    }
                if (isk) { kmx = fmaxf(kmx, __shfl_xor(kmx, 1)); kmx = fmaxf(kmx, __shfl_xor(kmx, 2)); kmx = fmaxf(kmx, __shfl_xor(kmx, 4)); kmx = fmaxf(kmx, __shfl_xor(kmx, 8));
                    if (fr == 0 && fqo == 0) { const int grp = pn == 1 ? 0 : 1; const int head = pn == 1 ? bj * 2 + (wc >> 1) : (wc >> 1);
                        atomicMax(kmax + (grp * 4 + head) * 2 + (wc & 1), __float_as_uint(kmx * 1.02f)); } }
            }
        } else {
            const bool isq = (pn == 6) || (wc < 2);
            const int hcol = (pn == 6) ? 64 * wc : (wc < 2 ? 64 * (4 + wc) : 64 * (wc - 2));
            bf16_t* base = qkv + (isq ? OFF_QC : OFF_KC) + hcol + 8 * fqo;
            const int pitch = isq ? 384 : 128;
            const float* gw = (isq ? gq : gk) + 4 * fqo;
            const float osc = isq ? 0.125f * 1.4426950408889634f : 1.0f;
#pragma unroll
            for (int ai = 0; ai < 2; ++ai)
#pragma unroll
                for (int m = 0; m < 4; ++m) {
                    const int row = row0 + ai * HALF + m * 16; const int t = row & 16383;
                    const float rv = rsqrtf(rowss[row] * (1.0f / 1024.0f) + 1e-6f);
                    float ss = 0.f; f32x4 hv[2][2];
#pragma unroll
                    for (int bj = 0; bj < 2; ++bj)
#pragma unroll
                        for (int n = 0; n < 2; ++n) { const f32x4 v = acc[ai][bj][m][n] * rv + *(const f32x4*)(bp + bj * HALF + 4 * n); hv[bj][n] = v; ss += (v[0] * v[0] + v[1] * v[1]) + (v[2] * v[2] + v[3] * v[3]); }
                    ss += __shfl_xor(ss, 16); ss += __shfl_xor(ss, 32);
                    const float rinv = rsqrtf(ss * (1.0f / 64.0f) + 1e-6f) * osc;
#pragma unroll
                    for (int bj = 0; bj < 2; ++bj) {
                        const int pos = bj == 0 ? (t >> 6) : (t & 63);
                        const f32x4 c = *(const f32x4*)(ropec + pos * 16 + 4 * fqo), s = *(const f32x4*)(ropes + pos * 16 + 4 * fqo);
                        const f32x4 x1 = hv[bj][0] * rinv * *(const f32x4*)(gw + 32 * bj), x2 = hv[bj][1] * rinv * *(const f32x4*)(gw + 32 * bj + 16);
                        const f32x4 o1 = x1 * c - x2 * s, o2 = x2 * c + x1 * s;
                        u32x4 w; w.x = pk_bf16(o1[0], o1[1]); w.y = pk_bf16(o1[2], o1[3]); w.z = pk_bf16(o2[0], o2[1]); w.w = pk_bf16(o2[2], o2[3]);
                        *(u32x4*)(base + (size_t)row * pitch + 32 * bj) = w;
                    }
                    asm volatile("" ::: "memory");
                }
        }
    }
};

template <bool GN> struct EpiResid {
    static constexpr bool PERM = true, AFTER_DRAIN = false, PROBE2 = false, KHOOK = GN;
    const bf16_t* base; bf16_t* out; const float* gate; int gstride;
    float* rowss;
    unsigned* pcnt;
    const float* gss;
    __device__ __forceinline__ void khook(f32x4 (&acc)[2][2][4][2], const Unit& u, int t, int wr, int fr) const {
        const int row0 = u.pm * BM + wr * 64 + fr;
        const float* s0 = gss + (t == 4 ? 0 : 32768); const float w0 = t == 4 ? (1.0f / 256.0f) : (1.0f / 384.0f);
#pragma unroll
        for (int ai = 0; ai < 2; ++ai)
#pragma unroll
            for (int m = 0; m < 4; ++m) { const int row = row0 + ai * HALF + m * 16;
                const float ratio = rsqrtf(s0[row] * w0 + 1e-6f) * __builtin_sqrtf(s0[32768 + row] * (1.0f / 384.0f) + 1e-6f);
#pragma unroll
                for (int bj = 0; bj < 2; ++bj)
#pragma unroll
                    for (int n = 0; n < 2; ++n) acc[ai][bj][m][n] *= ratio; }
    }
    __device__ __forceinline__ void operator()(const f32x4 (&acc)[2][2][4][2], const Unit& u, int wr, int wc, int fr, int fq) const {
        const int row0 = u.pm * BM + wr * 64 + fr; const int b = (u.pm * BM) >> 14;
        int fqo = fq; asm volatile("" : "+v"(fqo));
        const int col0 = u.pn * BM + wc * 32 + 8 * fqo;
        float ss[2][4];
#pragma unroll
        for (int ai = 0; ai < 2; ++ai)
#pragma unroll
            for (int m = 0; m < 4; ++m) ss[ai][m] = 0.f;
#pragma unroll
        for (int bj = 0; bj < 2; ++bj) {
            f32x4 gv[2];
#pragma unroll
            for (int n = 0; n < 2; ++n) gv[n] = *(const f32x4*)(gate + (size_t)b * gstride + col0 + bj * HALF + 4 * n);
            u32x4 pq[2][4];
#pragma unroll
            for (int ai = 0; ai < 2; ++ai)
#pragma unroll
                for (int m = 0; m < 4; ++m) pq[ai][m] = *(const u32x4*)(base + (size_t)(row0 + ai * HALF + m * 16) * 1024 + col0 + bj * HALF);
            asm volatile("" ::: "memory");
#pragma unroll
            for (int ai = 0; ai < 2; ++ai) {
#pragma unroll
                for (int m = 0; m < 4; ++m) { const size_t off = (size_t)(row0 + ai * HALF + m * 16) * 1024 + col0 + bj * HALF;
                    float rc = 1.0f; if constexpr (GN) rc = rsqrtf(gss[2 * 32768 + row0 + ai * HALF + m * 16] * (1.0f / 384.0f) + 1e-6f);
                    const u32x4 q = pq[ai][m];
                    const f32x2 qa_ = up_f16(q.x), qb_ = up_f16(q.y), qc_ = up_f16(q.z), qd_ = up_f16(q.w);
                    const f32x4 x0 = (f32x4){qa_[0], qa_[1], qb_[0], qb_[1]} + gv[0] * (acc[ai][bj][m][0] * rc),
                                x1 = (f32x4){qc_[0], qc_[1], qd_[0], qd_[1]} + gv[1] * (acc[ai][bj][m][1] * rc);
                    { u32x4 wx; wx.x = pk_f16(x0[0], x0[1]); wx.y = pk_f16(x0[2], x0[3]); wx.z = pk_f16(x1[0], x1[1]); wx.w = pk_f16(x1[2], x1[3]); *(u32x4*)(out + off) = wx; }
                    ss[ai][m] += ((x0[0] * x0[0] + x0[1] * x0[1]) + (x0[2] * x0[2] + x0[3] * x0[3])) + ((x1[0] * x1[0] + x1[1] * x1[1]) + (x1[2] * x1[2] + x1[3] * x1[3]));
                }
                asm volatile("" ::: "memory");
            }
        }
#pragma unroll
        for (int ai = 0; ai < 2; ++ai)
#pragma unroll
            for (int m = 0; m < 4; ++m) { float t = ss[ai][m]; t += __shfl_xor(t, 16); t += __shfl_xor(t, 32);
                if (fq == 0) atomicAdd(rowss + row0 + ai * HALF + m * 16, t); }
        if (pcnt) { asm volatile("s_waitcnt vmcnt(0)" ::: "memory");
            if (fr == 0 && fq == 0) __hip_atomic_fetch_add(pcnt + 64 * u.pm, 1u, __ATOMIC_RELAXED, __HIP_MEMORY_SCOPE_AGENT); }
    }
};

struct EpiSwiGLU {
    static constexpr bool PERM = true, AFTER_DRAIN = false, PROBE2 = true, KHOOK = false;
    bf16_t* act; const float* rowss; const float* bias;
    __device__ __forceinline__ void operator()(const f32x4 (&acc)[2][2][4][2], const Unit& u, int wr, int wc, int fr, int fq) const {
        const int row0 = u.pm * BM + wr * 64 + fr; const int col0 = u.pn * HALF + wc * 32 + 8 * fq;
        const float* bp = bias + (size_t)((u.pm * BM) >> 14) * 5632 + u.pn * BM + wc * 32 + 8 * fq;
        f32x4 bz[2][2];
#pragma unroll
        for (int bj = 0; bj < 2; ++bj)
#pragma unroll
            for (int n = 0; n < 2; ++n) bz[bj][n] = *(const f32x4*)(bp + bj * HALF + 4 * n);
#pragma unroll
        for (int ai = 0; ai < 2; ++ai)
#pragma unroll
            for (int m = 0; m < 4; ++m) {
                float o[8]; const float rv = rsqrtf(rowss[row0 + ai * HALF + m * 16] * (1.0f / 1024.0f) + 1e-6f);
#pragma unroll
                for (int n = 0; n < 2; ++n)
#pragma unroll
                    for (int j = 0; j < 4; ++j) { const float g = acc[ai][0][m][n][j] * rv + bz[0][n][j], up = acc[ai][1][m][n][j] * rv + bz[1][n][j];
                        o[4 * n + j] = g * __builtin_amdgcn_rcpf(1.0f + __expf(-g)) * up; }
                u32x4 w; w.x = pk_bf16(o[0], o[1]); w.y = pk_bf16(o[2], o[3]); w.z = pk_bf16(o[4], o[5]); w.w = pk_bf16(o[6], o[7]);
                *(u32x4*)(act + (size_t)(row0 + ai * HALF + m * 16) * 2816 + col0) = w;
            }
    }
};

typedef _Float16 f16x8_t __attribute__((ext_vector_type(8)));
template <bool F16> __device__ __forceinline__ f32x4 mma16(bf16x8 b, bf16x8 a, f32x4 c) {
    if constexpr (F16) return __builtin_amdgcn_mfma_f32_16x16x32_f16(__builtin_bit_cast(f16x8_t, b), __builtin_bit_cast(f16x8_t, a), c, 0, 0, 0);
    else return __builtin_amdgcn_mfma_f32_16x16x32_bf16(b, a, c, 0, 0, 0);
}
template <class Epi, class Sched, bool ALIGN_EPI = false, bool SP2 = false, bool F16 = false>
__device__ __forceinline__ void gemm_phase(PG8_LAS unsigned char* lds, const Gemm g, const Sched& S, const Epi& E) {
    int tid_l = threadIdx.x; asm volatile("" : "+v"(tid_l));
    const int tid = tid_l, wid = __builtin_amdgcn_readfirstlane(tid >> 6), lane = tid & 63, wr = wid >> 2, wc = wid & 3, fr = lane & 15, fq = lane >> 4;
    const int K = g.K, nt = K / BK;
    unsigned voffA[2], voffB[2];
#pragma unroll
    for (int i = 0; i < 2; ++i) { int R, C; stage_rc(tid * 16 + i * 8192, R, C); const int Rb = Epi::PERM ? ((R & ~31) + perm32(R & 31)) : R;
        voffA[i] = (unsigned)(R * K + C) * 2u; voffB[i] = (unsigned)(Rb * K + C) * 2u; }
    const size_t kstep = (size_t)(BK * 2);
    const size_t hstep = (size_t)HALF * K * 2;
    const size_t tstep = 2 * hstep;
    const unsigned ldsw = (unsigned)wid * 1024u;
    const int aoff = lds_byte(wr * 64 + fr, fq * 8), boff = lds_byte(wc * 32 + fr, fq * 8);
#define PG8_SA(b, h) (((b) * 2 + (h)) * HTB)
#define PG8_SB(b, h) ((4 + (b) * 2 + (h)) * HTB)
#define PG8_STAGE(bufoff, gbase, voff) do { _Pragma("unroll") for (int _i = 0; _i < 2; ++_i) \
        __builtin_amdgcn_global_load_lds((const unsigned*)((const char*)(gbase) + (voff)[_i]), (PG8_LAS unsigned*)(lds + (bufoff) + ldsw + _i * 8192), 16, 0, 0); } while (0)
#define PG8_LDA(dst, b, h) do { _Pragma("unroll") for (int m = 0; m < 4; ++m) _Pragma("unroll") for (int k = 0; k < 2; ++k) dst[m][k] = *(const PG8_LAS bf16x8*)(lds + PG8_SA(b, h) + aoff + m * 2048 + k * 1024); } while (0)
#define PG8_LDB(dst, b, h) do { _Pragma("unroll") for (int n = 0; n < 2; ++n) _Pragma("unroll") for (int k = 0; k < 2; ++k) dst[n][k] = *(const PG8_LAS bf16x8*)(lds + PG8_SB(b, h) + boff + n * 2048 + k * 1024); } while (0)
#define PG8_MMA(ai, bj, At, Bt) do { __builtin_amdgcn_s_setprio(1); _Pragma("unroll") for (int m = 0; m < 4; ++m) _Pragma("unroll") for (int n = 0; n < 2; ++n) _Pragma("unroll") for (int k = 0; k < 2; ++k) \
        acc[ai][bj][m][n] = mma16<F16>(Bt[n][k], At[m][k], acc[ai][bj][m][n]); __builtin_amdgcn_s_setprio(0); } while (0)
#define PG8_WAIT_V(n) asm volatile("s_waitcnt vmcnt(" #n ")" ::: "memory")
#define PG8_WAIT_L(n) asm volatile("s_waitcnt lgkmcnt(" #n ")" ::: "memory")
#define PG8_BAR __builtin_amdgcn_s_barrier()
#define PG8_SCHED __builtin_amdgcn_sched_barrier(0)
    Unit cur, nxt; int ui = 0;
    if (!S.next(0, cur)) return;
    f32x4 acc[2][2][4][2];
#pragma unroll
    for (int a = 0; a < 2; ++a)
#pragma unroll
        for (int b = 0; b < 2; ++b)
#pragma unroll
            for (int m = 0; m < 4; ++m)
#pragma unroll
                for (int n = 0; n < 2; ++n) acc[a][b][m][n] = (f32x4){0.f, 0.f, 0.f, 0.f};
    bf16x8 At[4][2], B0[2][2], B1[2][2];
    const char* cA = (const char*)g.A + (size_t)cur.pm * tstep; const char* cB = (const char*)g.Bt + (size_t)cur.pn * tstep + (cur.pm >= g.mhalf ? g.bstride : (size_t)0);
    S.a_ready(cur);
    if constexpr (SP2) {
        PG8_STAGE(PG8_SB(0, 0), cB, voffB); PG8_STAGE(PG8_SB(0, 1), cB + hstep, voffB); PG8_STAGE(PG8_SA(0, 0), cA, voffA); PG8_STAGE(PG8_SA(0, 1), cA + hstep, voffA);
        if (wr == 1) PG8_BAR;
        PG8_WAIT_V(2); PG8_BAR;
        PG8_STAGE(PG8_SB(1, 0), cB + kstep, voffB); PG8_STAGE(PG8_SA(1, 0), cA + kstep, voffA); PG8_STAGE(PG8_SB(1, 1), cB + hstep + kstep, voffB);
        PG8_WAIT_V(6); PG8_BAR;
    } else {
        PG8_STAGE(PG8_SB(0, 0), cB, voffB); PG8_STAGE(PG8_SA(0, 0), cA, voffA); PG8_STAGE(PG8_SB(0, 1), cB + hstep, voffB); PG8_STAGE(PG8_SA(0, 1), cA + hstep, voffA);
        if (wr == 1) PG8_BAR;
        PG8_WAIT_V(4); PG8_BAR;
        PG8_STAGE(PG8_SB(1, 0), cB + kstep, voffB); PG8_STAGE(PG8_SA(1, 0), cA + kstep, voffA); PG8_STAGE(PG8_SB(1, 1), cB + hstep + kstep, voffB);
        PG8_WAIT_V(6); PG8_BAR;
    }
    for (;;) {
        const bool has_next = S.next(ui + 1, nxt);
        const char* nA = has_next ? (const char*)g.A + (size_t)nxt.pm * tstep : cA; const char* nB = has_next ? (const char*)g.Bt + (size_t)nxt.pn * tstep + (nxt.pm >= g.mhalf ? g.bstride : (size_t)0) : cB;
        for (int t = 0; t < nt; t += 2) {
            if constexpr (Epi::KHOOK) { if (t == 4 || t == 10) E.khook(acc, cur, t, wr, fr); }
            const bool last = (t == nt - 2);
            const char* a1 = cA + (size_t)(t + 1) * kstep;
            const char* a2 = last ? nA : cA + (size_t)(t + 2) * kstep; const char* b2 = last ? nB : cB + (size_t)(t + 2) * kstep;
            const char* a3 = a2 + kstep; const char* b3 = b2 + kstep;
            if (last && has_next) S.a_ready(nxt);
            if constexpr (SP2) {
            PG8_LDB(B0, 0, 0); PG8_LDB(B1, 0, 1); PG8_SCHED; PG8_LDA(At, 0, 0); PG8_STAGE(PG8_SA(1, 1), a1 + hstep, voffA);
            PG8_WAIT_V(8); PG8_WAIT_L(0); PG8_BAR; PG8_MMA(0, 0, At, B0); PG8_MMA(0, 1, At, B1); PG8_BAR; PG8_SCHED;
            PG8_LDA(At, 0, 1); PG8_STAGE(PG8_SB(0, 0), b2, voffB); PG8_STAGE(PG8_SB(0, 1), b2 + hstep, voffB); PG8_STAGE(PG8_SA(0, 0), a2, voffA);
            PG8_WAIT_V(8); PG8_WAIT_L(0); PG8_BAR; PG8_MMA(1, 0, At, B0); PG8_MMA(1, 1, At, B1); PG8_BAR; PG8_SCHED;
            PG8_LDB(B0, 1, 0); PG8_LDB(B1, 1, 1); PG8_SCHED; PG8_LDA(At, 1, 0); PG8_STAGE(PG8_SA(0, 1), a2 + hstep, voffA);
            PG8_WAIT_V(8); PG8_WAIT_L(0); PG8_BAR; PG8_MMA(0, 0, At, B0); PG8_MMA(0, 1, At, B1); PG8_BAR; PG8_SCHED;
            PG8_LDA(At, 1, 1); PG8_STAGE(PG8_SB(1, 0), b3, voffB); PG8_STAGE(PG8_SB(1, 1), b3 + hstep, voffB); PG8_STAGE(PG8_SA(1, 0), a3, voffA);
            PG8_WAIT_V(8); PG8_WAIT_L(0); PG8_BAR; PG8_MMA(1, 0, At, B0); PG8_MMA(1, 1, At, B1); PG8_BAR; PG8_SCHED;
            } else {
            PG8_LDB(B0, 0, 0); PG8_SCHED; PG8_LDA(At, 0, 0); PG8_STAGE(PG8_SA(1, 1), a1 + hstep, voffA);
            PG8_WAIT_L(8); PG8_BAR; PG8_WAIT_L(0); PG8_MMA(0, 0, At, B0); PG8_BAR; PG8_SCHED;
            PG8_LDB(B1, 0, 1); PG8_STAGE(PG8_SB(0, 0), b2, voffB);
            PG8_BAR; PG8_WAIT_L(0); PG8_MMA(0, 1, At, B1); PG8_BAR;
            PG8_LDA(At, 0, 1); PG8_STAGE(PG8_SA(0, 0), a2, voffA);
            PG8_BAR; PG8_WAIT_L(0); PG8_MMA(1, 0, At, B0); PG8_BAR; PG8_SCHED;
            PG8_STAGE(PG8_SB(0, 1), b2 + hstep, voffB);
            PG8_WAIT_V(6); PG8_BAR; PG8_MMA(1, 1, At, B1); PG8_BAR;
            PG8_LDB(B0, 1, 0); PG8_SCHED; PG8_LDA(At, 1, 0); PG8_STAGE(PG8_SA(0, 1), a2 + hstep, voffA);
            PG8_WAIT_L(8); PG8_BAR; PG8_WAIT_L(0); PG8_MMA(0, 0, At, B0); PG8_BAR; PG8_SCHED;
            PG8_LDB(B1, 1, 1); PG8_STAGE(PG8_SB(1, 0), b3, voffB);
            PG8_BAR; PG8_WAIT_L(0); PG8_MMA(0, 1, At, B1); PG8_BAR;
            PG8_LDA(At, 1, 1); PG8_STAGE(PG8_SA(1, 0), a3, voffA);
            PG8_BAR; PG8_WAIT_L(0); PG8_MMA(1, 0, At, B0); PG8_BAR; PG8_SCHED;
            PG8_STAGE(PG8_SB(1, 1), b3 + hstep, voffB);
            PG8_WAIT_V(6); PG8_BAR; PG8_MMA(1, 1, At, B1); PG8_BAR;
            }
        }
        if constexpr (ALIGN_EPI) { if (wr == 0) PG8_BAR; }
        if constexpr (!Epi::AFTER_DRAIN) { E(acc, cur, wr, wc, fr, fq);
#if PROBE_EPI
            if constexpr (Epi::PROBE2) { asm volatile("" ::: "memory"); E(acc, cur, wr, wc, fr, fq); }
#endif
            S.done(cur); }
        if (!has_next) break;
#pragma unroll
        for (int a = 0; a < 2; ++a)
#pragma unroll
            for (int b = 0; b < 2; ++b)
#pragma unroll
                for (int m = 0; m < 4; ++m)
#pragma unroll
                    for (int n = 0; n < 2; ++n) acc[a][b][m][n] = (f32x4){0.f, 0.f, 0.f, 0.f};
        cur = nxt; cA = nA; cB = nB; ++ui;
        if constexpr (ALIGN_EPI) { if (wr == 1) PG8_BAR; }
    }
    PG8_WAIT_V(0);
    if constexpr (!ALIGN_EPI) { if (wr == 0) PG8_BAR; }
    PG8_BAR;
    if constexpr (Epi::AFTER_DRAIN) { E.fused(acc, cur, wr, wc, fr, fq, lds, wid, lane); S.done(cur); }
#undef PG8_SA
#undef PG8_SB
#undef PG8_STAGE
#undef PG8_LDA
#undef PG8_LDB
#undef PG8_MMA
#undef PG8_WAIT_V
#undef PG8_WAIT_L
#undef PG8_BAR
#undef PG8_SCHED
}
}
namespace attn_body {
using bf16=__hip_bfloat16;
using bf16x8=__attribute__((ext_vector_type(8)))short;
using s16x4=__attribute__((ext_vector_type(4)))short;
using f32x16=__attribute__((ext_vector_type(16)))float;
using u32x4=__attribute__((ext_vector_type(4)))unsigned;
constexpr int SEQ=16384,D=64,QP=384,KP=128,OP=1024;
constexpr int NW=8,QBLK=32,QB=QBLK*NW,KVBLK=64,NQB=SEQ/QB;
constexpr int ATTN_UNIT_ROWS=QB;
__device__ __forceinline__ int crow(int r,int hi){return (r&3)+8*(r>>2)+4*hi;}
#define SBAR() __builtin_amdgcn_sched_barrier(0)
__device__ __forceinline__ void cmask(f32x16&p0,f32x16&p1,int jb,int qrel,int hi){
  const float NEG=-INFINITY; int kb=64*jb+4*hi;
  #pragma unroll
  for(int r=0;r<16;++r){int kv=kb+(r&3)+8*(r>>2); if(kv>qrel)p0[r]=NEG; if(kv+32>qrel)p1[r]=NEG;}
}

constexpr int NSLOT=3, SLOTB=8192;
constexpr int LDS_K=0, LDS_V=NSLOT*SLOTB, LDS_WS=2*NSLOT*SLOTB, LDS_OST=LDS_WS+NW*64*4, LDS_BYTES=LDS_OST+NW*4096;
constexpr float C2=0.125f*1.4426950408889634f;
__device__ __forceinline__ void glds16(const void*gsrc,unsigned lds_dst){unsigned keep;
  asm volatile("s_mov_b32 %0, m0\n\ts_mov_b32 m0, %2\n\ts_nop 0\n\tglobal_load_lds_dwordx4 %1, off\n\ts_mov_b32 m0, %0":"=&s"(keep):"v"(gsrc),"s"(lds_dst):"memory");}
__device__ __forceinline__ float max3f(float a,float b,float c){float r;asm("v_max3_f32 %0, %1, %2, %3":"=v"(r):"v"(a),"v"(b),"v"(c));return r;}
__device__ __forceinline__ float max2f(float a,float b){float r;asm("v_max_f32_e32 %0, %1, %2":"=v"(r):"v"(a),"v"(b));return r;}
__device__ __forceinline__ float fadd_s(float a,float b){float r;asm("v_add_f32_e32 %0, %1, %2":"=v"(r):"v"(a),"v"(b));return r;}
__device__ __forceinline__ float fsub_s(float a,float b){float r;asm("v_sub_f32_e32 %0, %1, %2":"=v"(r):"v"(a),"v"(b));return r;}
typedef float f32x2_t __attribute__((ext_vector_type(2))); typedef __bf16 bf16x2_t __attribute__((ext_vector_type(2)));
__device__ __forceinline__ unsigned cvtpk_s(float lo,float hi){f32x2_t v={lo,hi};bf16x2_t b=__builtin_convertvector(v,bf16x2_t);return __builtin_bit_cast(unsigned,b);}
#define WAIT_BAR(N) asm volatile("s_waitcnt vmcnt(" #N ") lgkmcnt(0)\n\ts_barrier":::"memory")

__device__ __forceinline__ void qkt(f32x16&p0,f32x16&p1,const char*Kslot,const bf16x8*qr,const f32x16&negm,int r32,int hi){
  const char*kb=Kslot+hi*1024+r32*16;
  #pragma unroll
  for(int d0=0;d0<4;++d0){
    const bf16x8 b0=*reinterpret_cast<const bf16x8*>(kb+d0*2048);
    const bf16x8 b1=*reinterpret_cast<const bf16x8*>(kb+d0*2048+512);
    if(d0==0){p0=__builtin_amdgcn_mfma_f32_32x32x16_bf16(b0,qr[0],negm,0,0,0);p1=__builtin_amdgcn_mfma_f32_32x32x16_bf16(b1,qr[0],negm,0,0,0);}
    else{p0=__builtin_amdgcn_mfma_f32_32x32x16_bf16(b0,qr[d0],p0,0,0,0);p1=__builtin_amdgcn_mfma_f32_32x32x16_bf16(b1,qr[d0],p1,0,0,0);}}
}
typedef __attribute__((address_space(3))) const char* lds_cptr;
typedef short v4i16_t __attribute__((ext_vector_type(4)));
__device__ __forceinline__ void kload8(bf16x8*kf,lds_cptr kp){
  kf[0]=*(const __attribute__((address_space(3))) bf16x8*)(kp);      kf[1]=*(const __attribute__((address_space(3))) bf16x8*)(kp+512);
  kf[2]=*(const __attribute__((address_space(3))) bf16x8*)(kp+2048); kf[3]=*(const __attribute__((address_space(3))) bf16x8*)(kp+2560);
  kf[4]=*(const __attribute__((address_space(3))) bf16x8*)(kp+4096); kf[5]=*(const __attribute__((address_space(3))) bf16x8*)(kp+4608);
  kf[6]=*(const __attribute__((address_space(3))) bf16x8*)(kp+6144); kf[7]=*(const __attribute__((address_space(3))) bf16x8*)(kp+6656);
}
__device__ __forceinline__ void kload2(bf16x8*kf,lds_cptr kp,int j){ kf[2*j]=*(const __attribute__((address_space(3))) bf16x8*)(kp+j*2048); kf[2*j+1]=*(const __attribute__((address_space(3))) bf16x8*)(kp+j*2048+512); }
__device__ __forceinline__ s16x4 vtr(lds_cptr p){ return __builtin_bit_cast(s16x4,__builtin_amdgcn_ds_read_tr16_b64_v4i16((__attribute__((address_space(3))) v4i16_t*)p)); }
__device__ __forceinline__ float rowmax(const f32x16&p0,const f32x16&p1){
  float a=max3f(p0[0],p0[1],p1[0]),b=max3f(p0[2],p0[3],p1[1]);a=max3f(a,p1[2],p1[3]);
  #pragma unroll
  for(int r=4;r<16;r+=4){a=max3f(a,p0[r],p0[r+1]);b=max3f(b,p0[r+2],p0[r+3]);a=max3f(a,p1[r],p1[r+1]);b=max3f(b,p1[r+2],p1[r+3]);}
  const float m=max2f(a,b);
  auto rr=__builtin_amdgcn_permlane32_swap(__float_as_uint(m),__float_as_uint(m),false,false);
  return max2f(__uint_as_float(rr[0]),__uint_as_float(rr[1]));
}
__device__ __forceinline__ void pv(f32x16*o,int vb,bf16x8 pa0,bf16x8 pa1,bf16x8 pa2,bf16x8 pa3){
  #pragma unroll
  for(int d0=0;d0<2;++d0){s16x4 lo[4],hi[4];
    #pragma unroll
    for(int ks=0;ks<4;++ks){
      asm volatile("ds_read_b64_tr_b16 %0,%1 offset:%c2":"=&v"(lo[ks]):"v"(vb),"i"(d0*4096+ks*1024):"memory");
      asm volatile("ds_read_b64_tr_b16 %0,%1 offset:%c2":"=&v"(hi[ks]):"v"(vb),"i"(d0*4096+ks*1024+512):"memory");}
    asm volatile("s_waitcnt lgkmcnt(0)":::"memory");SBAR();
    #define PK(k) (bf16x8){lo[k][0],lo[k][1],lo[k][2],lo[k][3],hi[k][0],hi[k][1],hi[k][2],hi[k][3]}
    o[d0]=__builtin_amdgcn_mfma_f32_32x32x16_bf16(pa0,PK(0),o[d0],0,0,0);
    o[d0]=__builtin_amdgcn_mfma_f32_32x32x16_bf16(pa1,PK(1),o[d0],0,0,0);
    o[d0]=__builtin_amdgcn_mfma_f32_32x32x16_bf16(pa2,PK(2),o[d0],0,0,0);
    o[d0]=__builtin_amdgcn_mfma_f32_32x32x16_bf16(pa3,PK(3),o[d0],0,0,0);
    #undef PK
  }
}

#ifndef ATTN_STORE16
#define ATTN_STORE16(p,v) (*(u32x4*)(p)=(v))
#endif
template<int THRL> __device__ __forceinline__ void attn_unit(int b,int h,int qb,const bf16*Q,const bf16*__restrict__ K,const bf16*__restrict__ V,bf16*O,float*gssrow,float mref,char*shm){
  int tid_l=threadIdx.x; asm volatile("":"+v"(tid_l)); const int tid=tid_l,lane=tid&63,r32=lane&31,hi=lane>>5; const int wid=__builtin_amdgcn_readfirstlane(tid>>6);
  const long rowbase=(long)b*SEQ; const int q0=qb*QB;
  const bf16*Qw=Q+(rowbase+q0+wid*QBLK)*QP+h*D;
  const int g=h/3; const bf16*Kh=K+rowbase*KP+g*D,*Vh=V+rowbase*KP+g*D;
  const unsigned lds0=(unsigned)(uintptr_t)shm;
  float*wsf=(float*)(shm+LDS_WS)+wid*64;
  const bf16*ksrc=Kh+(long)lane*KP+wid*8;
  const bf16*vsrc=Vh+(long)(16*(wid&3)+(lane>>2))*KP+(wid>>2)*32+(lane&3)*8;
  const unsigned kdst=lds0+LDS_K+wid*1024, vdst=lds0+LDS_V+wid*1024;
  #define DMA_K(t,slot) glds16(ksrc+(long)(t)*KVBLK*KP,(unsigned)__builtin_amdgcn_readfirstlane(kdst+(slot)))
  #define DMA_V(t,slot) glds16(vsrc+(long)(t)*KVBLK*KP,(unsigned)__builtin_amdgcn_readfirstlane(vdst+(slot)))
  const int vb0=(int)(lds0+LDS_V)+((lane>>4)&1)*32+(lane&3)*8+(4*hi+((lane&15)>>2))*64;
  const char*Kbase=shm+LDS_K; bf16x8 kf[8];
  const lds_cptr shm3=(lds_cptr)shm; const lds_cptr kp0=shm3+LDS_K+hi*1024+r32*16; const lds_cptr vp0=shm3+LDS_V+((lane>>4)&1)*32+(lane&3)*8+(4*hi+((lane&15)>>2))*64;
  const int NT=SEQ/KVBLK;
  DMA_K(0,0);DMA_V(0,0);DMA_K(1,SLOTB);
  bf16x8 qr[4];
  #pragma unroll
  for(int d0=0;d0<4;++d0)qr[d0]=*reinterpret_cast<const bf16x8*>(&Qw[(long)r32*QP+d0*16+hi*8]);
  float l_reg=0.f;f32x16 o[2];o[0]=f32x16{};o[1]=f32x16{};f32x16 negm;_Pragma("unroll") for(int r=0;r<16;++r)negm[r]=-mref;asm volatile("":"+v"(negm));

  #define CMASK(P0,P1,t) do{}while(0)
  #define START(P0,P1) do{ _Pragma("unroll") for(int r=0;r<16;++r)P0[r]=__builtin_amdgcn_exp2f(P0[r]); }while(0)
  #define RESC() do{}while(0)
  f32x16 pA0,pA1,pB0,pB1;
  int sl_prev=0,sl_cur=0,sl_next=SLOTB;
  #define ROT() do{sl_prev=sl_cur;sl_cur=sl_next;sl_next=(sl_next==(NSLOT-1)*SLOTB)?0:sl_next+SLOTB;}while(0)
  DMA_K(2,2*SLOTB);
  WAIT_BAR(3);
  qkt(pA0,pA1,Kbase,qr,negm,r32,hi);asm volatile("s_nop 15\n\ts_nop 7":"+v"(pA0),"+v"(pA1));CMASK(pA0,pA1,0);
  START(pA0,pA1);
  _Pragma("unroll") for(int r=0;r<16;++r)pA1[r]=__builtin_amdgcn_exp2f(pA1[r]);
  WAIT_BAR(0);
  DMA_K(3,0);DMA_V(1,SLOTB);
  ROT();
  kload8(kf,kp0+sl_cur);
  WAIT_BAR(2);
  s16x4 vlo[8],vhi[8]; u32x4 pw0,pw1,pw2,pw3;
  #define PKW(P,B) cvtpk_s(P[B],P[B+1])
  #define PAF(k) __builtin_bit_cast(bf16x8,pw##k)
  #define VFR(i) (bf16x8){vlo[i][0],vlo[i][1],vlo[i][2],vlo[i][3],vhi[i][0],vhi[i][1],vhi[i][2],vhi[i][3]}
  #define PIN(x) asm volatile("":"+v"(x))
  #define MX3(a,b,c) __builtin_fmaxf(__builtin_fmaxf((a),(b)),(c))
  #define GAPA(MF,A0,A1,A2,A3,W0,W1,PW) do{ MF; sacc+=A0; sacc+=A1; sacc+=A2; sacc+=A3; PIN(sacc); W0; W1; PIN(PW); SBAR(); }while(0)
  #define EX(v) __builtin_amdgcn_exp2f(v)
  #define GAPB(MF,X,B) do{ MF; X[B]=EX(X[B]); X[B+1]=EX(X[B+1]); X[B+2]=EX(X[B+2]); X[B+3]=EX(X[B+3]); PIN(X); SBAR(); }while(0)
  #define VRD(i) do{ vlo[i]=vtr(vp_+(((i)>>2)*4096+((i)&3)*1024)); vhi[i]=vtr(vp_+(((i)>>2)*4096+((i)&3)*1024+512)); }while(0)
  #define KRD(G,j) do{ if(G){ kload2(kf,kp0+sl_next,j); SBAR(); } }while(0)
  #define STEP(C0,C1,P0,P1,t,GK,GV,GL) do{ SBAR(); \
    const lds_cptr vp_=vp0+sl_prev; \
    VRD(0); SBAR(); float sacc=(P0[0]+P0[1]); \
    GAPA(C0=__builtin_amdgcn_mfma_f32_32x32x16_bf16(kf[0],qr[0],negm,0,0,0), P0[2],P0[3],P0[4],P0[5],     pw0[0]=PKW(P0,0), pw0[1]=PKW(P0,2), pw0); \
    VRD(4); SBAR(); GAPA(C1=__builtin_amdgcn_mfma_f32_32x32x16_bf16(kf[1],qr[0],negm,0,0,0), P0[6],P0[7],P0[8],P0[9],     pw0[2]=PKW(P0,4), pw0[3]=PKW(P0,6), pw0); \
    VRD(1); SBAR(); GAPA(C0=__builtin_amdgcn_mfma_f32_32x32x16_bf16(kf[2],qr[1],C0,0,0,0),   P0[10],P0[11],P0[12],P0[13], pw1[0]=PKW(P0,8), pw1[1]=PKW(P0,10), pw1); \
    VRD(5); SBAR(); GAPA(C1=__builtin_amdgcn_mfma_f32_32x32x16_bf16(kf[3],qr[1],C1,0,0,0),   P0[14],P0[15],P1[0],P1[1],   pw1[2]=PKW(P0,12),pw1[3]=PKW(P0,14), pw1); \
    VRD(2); SBAR(); GAPA(C0=__builtin_amdgcn_mfma_f32_32x32x16_bf16(kf[4],qr[2],C0,0,0,0),   P1[2],P1[3],P1[4],P1[5],     pw2[0]=PKW(P1,0), pw2[1]=PKW(P1,2), pw2); \
    VRD(6); SBAR(); GAPA(C1=__builtin_amdgcn_mfma_f32_32x32x16_bf16(kf[5],qr[2],C1,0,0,0),   P1[6],P1[7],P1[8],P1[9],     pw2[2]=PKW(P1,4), pw2[3]=PKW(P1,6), pw2); \
    VRD(3); SBAR(); GAPA(C0=__builtin_amdgcn_mfma_f32_32x32x16_bf16(kf[6],qr[3],C0,0,0,0),   P1[10],P1[11],P1[12],P1[13], pw3[0]=PKW(P1,8), pw3[1]=PKW(P1,10), pw3); \
    VRD(7); SBAR(); GAPA(C1=__builtin_amdgcn_mfma_f32_32x32x16_bf16(kf[7],qr[3],C1,0,0,0),   P1[14],P1[15],0.f,0.f,       pw3[2]=PKW(P1,12),pw3[3]=PKW(P1,14), pw3); \
    l_reg+=sacc; \
    if(GK){DMA_K((t)+3,sl_cur);} if(GV){DMA_V((t)+1,sl_next);} \
    CMASK(C0,C1,t); \
    SBAR(); \
    GAPB(o[0]=__builtin_amdgcn_mfma_f32_32x32x16_bf16(PAF(0),VFR(0),o[0],0,0,0), C0,0); \
    GAPB(o[1]=__builtin_amdgcn_mfma_f32_32x32x16_bf16(PAF(0),VFR(4),o[1],0,0,0), C0,4); \
    KRD(GL,0); GAPB(o[0]=__builtin_amdgcn_mfma_f32_32x32x16_bf16(PAF(1),VFR(1),o[0],0,0,0), C0,8); \
    KRD(GL,1); GAPB(o[1]=__builtin_amdgcn_mfma_f32_32x32x16_bf16(PAF(1),VFR(5),o[1],0,0,0), C0,12); \
    KRD(GL,2); GAPB(o[0]=__builtin_amdgcn_mfma_f32_32x32x16_bf16(PAF(2),VFR(2),o[0],0,0,0), C1,0); \
    KRD(GL,3); GAPB(o[1]=__builtin_amdgcn_mfma_f32_32x32x16_bf16(PAF(2),VFR(6),o[1],0,0,0), C1,4); \
    GAPB(o[0]=__builtin_amdgcn_mfma_f32_32x32x16_bf16(PAF(3),VFR(3),o[0],0,0,0), C1,8); \
    GAPB(o[1]=__builtin_amdgcn_mfma_f32_32x32x16_bf16(PAF(3),VFR(7),o[1],0,0,0), C1,12); \
    }while(0)
  if(wid>=4)__builtin_amdgcn_s_setprio(1);
  int t=1;
  #undef CMASK
  #define CMASK(P0,P1,t) do{}while(0)
  for(;t+5<NT;t+=2){
    STEP(pB0,pB1,pA0,pA1,t,true,true,true);     WAIT_BAR(2); RESC(); ROT();
    STEP(pA0,pA1,pB0,pB1,t+1,true,true,true);   WAIT_BAR(2); RESC(); ROT();
  }
  #undef CMASK
  #define CMASK(P0,P1,t) do{}while(0)
  #define ENDW(tt) do{ if((tt)+3<NT){WAIT_BAR(2);} else if((tt)+2<NT){WAIT_BAR(1);} else {WAIT_BAR(0);} }while(0)
  for(;t+1<NT;t+=2){
    STEP(pB0,pB1,pA0,pA1,t,(t+3<NT),(t+1<NT),(t+1<NT));       ENDW(t);   RESC(); ROT();
    STEP(pA0,pA1,pB0,pB1,t+1,(t+4<NT),(t+2<NT),(t+2<NT));     ENDW(t+1); RESC(); ROT();
  }
  STEP(pB0,pB1,pA0,pA1,NT-1,false,false,false); RESC();
  { float sacc=pB0[0]+pB0[1]; _Pragma("unroll") for(int r=2;r<16;++r)sacc+=pB0[r]; _Pragma("unroll") for(int r=0;r<16;++r)sacc+=pB1[r]; l_reg+=sacc;
    pw0=(u32x4){PKW(pB0,0),PKW(pB0,2),PKW(pB0,4),PKW(pB0,6)};pw1=(u32x4){PKW(pB0,8),PKW(pB0,10),PKW(pB0,12),PKW(pB0,14)};pw2=(u32x4){PKW(pB1,0),PKW(pB1,2),PKW(pB1,4),PKW(pB1,6)};pw3=(u32x4){PKW(pB1,8),PKW(pB1,10),PKW(pB1,12),PKW(pB1,14)};
    SBAR(); pv(o,vb0+sl_cur,PAF(0),PAF(1),PAF(2),PAF(3)); }
  #undef PKW
  #undef PAF
  #undef VFR
  #undef PIN
  #undef MX3
  #undef GAPA
  #undef GAPB
  #undef EX
  #undef VRD
  #undef KRD
  #undef STEP
  #undef ENDW
  __builtin_amdgcn_s_setprio(0);
  {auto rr=__builtin_amdgcn_permlane32_swap(__float_as_uint(l_reg),__float_as_uint(l_reg),false,false);l_reg=__uint_as_float(rr[0])+__uint_as_float(rr[1]);}
  if(hi==0)wsf[32+r32]=l_reg;asm volatile("s_waitcnt lgkmcnt(0)":::"memory");
  float rli[16];
  #pragma unroll
  for(int r=0;r<16;++r)rli[r]=__builtin_amdgcn_rcpf(wsf[32+crow(r,hi)]);
  bf16*Ow=O+(rowbase+q0+wid*QBLK)*OP+h*D;
  { bf16*stg=(bf16*)(shm+LDS_OST)+wid*2048;
    #pragma unroll
    for(int r=0;r<16;++r){const int orow=crow(r,hi);
      #pragma unroll
      for(int d0=0;d0<2;++d0)stg[orow*64+d0*32+r32]=__float2bfloat16(o[d0][r]*rli[r]);}
    asm volatile("s_waitcnt lgkmcnt(0)":::"memory");
    #pragma unroll
    for(int i=0;i<4;++i){const int row=i*8+(lane>>3),ch=lane&7; const u32x4 v=*(const u32x4*)(stg+row*64+ch*8); ATTN_STORE16(Ow+(long)row*OP+ch*8,v);
      float ss=0.f;
      #pragma unroll
      for(int e=0;e<4;++e){const float lo=__uint_as_float(v[e]<<16),hi_=__uint_as_float(v[e]&0xffff0000u); ss+=lo*lo+hi_*hi_;}
      ss+=__shfl_xor(ss,1); ss+=__shfl_xor(ss,2); ss+=__shfl_xor(ss,4);
      if(ch==0)atomicAdd(gssrow+rowbase+q0+wid*QBLK+row,ss);} }
  asm volatile("s_waitcnt lgkmcnt(0)\n\ts_barrier":::"memory");
  #undef DMA_K
  #undef DMA_V
  #undef CMASK
  #undef START
  #undef RESC
  #undef ROT
}
#undef SBAR
#undef WAIT_BAR
}
#define LAS __attribute__((address_space(3)))
typedef unsigned short bf16;
typedef unsigned v4u __attribute__((ext_vector_type(4)));
typedef unsigned v2u __attribute__((ext_vector_type(2)));
typedef float f32x4 __attribute__((ext_vector_type(4)));
typedef float f32x16 __attribute__((ext_vector_type(16)));
typedef short bf16x8 __attribute__((ext_vector_type(8)));
typedef short s16x4 __attribute__((ext_vector_type(4)));
using pg8::pk_bf16;

#define XB_TMO      128
#define XB_XCNT(j)  (256  + 64 * (j))
#define XB_XSUB(j)  (1280 + 64 * (j))
#define XB_XGEN(j)  (2304 + 64 * (j))
#define XB_TOP      3328
#define XB_TOPGEN   3392
#define XCD_BAR_WORDS 3456
#define XB_SPIN_CAP (1u << 18)

__device__ __forceinline__ unsigned xb_ld(unsigned* p)              { return __hip_atomic_load(p, __ATOMIC_RELAXED, __HIP_MEMORY_SCOPE_AGENT); }
__device__ __forceinline__ unsigned xb_add(unsigned* p, unsigned v) { return __hip_atomic_fetch_add(p, v, __ATOMIC_RELAXED, __HIP_MEMORY_SCOPE_AGENT); }
__device__ __forceinline__ unsigned xb_xcc_id() { return (unsigned)__builtin_amdgcn_s_getreg((3 << 11) | 20) & 0xFu; }
#define XB_SPIN(cond, bar) do { unsigned _sp = 0; while (cond) { __builtin_amdgcn_s_sleep(1); \
    if ((++_sp & 255u) == 0u) { if (xb_ld(&(bar)[XB_TMO])) break; if (_sp > XB_SPIN_CAP) { atomicAdd(&(bar)[XB_TMO], 1u); break; } } } } while (0)

struct XcdBarrier {
    unsigned* bar; unsigned x;
    volatile LAS unsigned* st;
};

__device__ __forceinline__ XcdBarrier xcd_barrier_post(unsigned* bar, volatile LAS unsigned* st) {
    XcdBarrier b; b.bar = bar; b.x = xb_xcc_id(); b.st = st;
    if (threadIdx.x == 0) (void)xb_add(&bar[XB_XCNT(b.x)], 1u);
    return b;
}
__device__ __forceinline__ void xcd_barrier_complete(unsigned* bar, unsigned x, unsigned& nloc, unsigned& nx) {
    const unsigned G = gridDim.x * gridDim.y * gridDim.z;
    unsigned sum, cnt, mine, sp = 0u;
    for (;;) {
        sum = 0u; cnt = 0u; mine = 0u;
#pragma unroll
        for (unsigned j = 0; j < 16; ++j) { const unsigned c = xb_ld(&bar[XB_XCNT(j)]); sum += c; cnt += (c > 0u) ? 1u : 0u; mine = (j == x) ? c : mine; }
        if (sum == G) break;
        __builtin_amdgcn_s_sleep(1);
        if ((++sp & 255u) == 0u) { if (xb_ld(&bar[XB_TMO])) break; if (sp > XB_SPIN_CAP) { atomicAdd(&bar[XB_TMO], 1u); break; } }
    }
    nloc = mine > 0u ? mine : 1u; nx = cnt > 0u ? cnt : 1u;
}

__device__ __forceinline__ void xcd_barrier(const XcdBarrier& b) {
    asm volatile("s_waitcnt vmcnt(0)" ::: "memory");
    __syncthreads();
    if (threadIdx.x == 0) {
        unsigned* bar = b.bar;
        __builtin_amdgcn_s_waitcnt(0);
        unsigned nloc = b.st[0], nx = b.st[1];
        if (nloc == 0u) { xcd_barrier_complete(bar, b.x, nloc, nx); b.st[0] = nloc; b.st[1] = nx; }
        const unsigned old = xb_add(&bar[XB_XSUB(b.x)], 1u);
        const unsigned gen = old / nloc;
        if (old + 1u == (gen + 1u) * nloc) {
            __builtin_amdgcn_fence(__ATOMIC_RELEASE, "agent");
            asm volatile("s_waitcnt vmcnt(0)" ::: "memory");
            const unsigned og = xb_add(&bar[XB_TOP], 1u);
            const unsigned tg = og / nx;
            if (og + 1u == (tg + 1u) * nx) xb_add(&bar[XB_TOPGEN], 1u);
            else XB_SPIN(xb_ld(&bar[XB_TOPGEN]) == tg, bar);
            __builtin_amdgcn_fence(__ATOMIC_ACQUIRE, "agent");
            xb_add(&bar[XB_XGEN(b.x)], 1u);
            asm volatile("s_waitcnt vmcnt(0)" ::: "memory");
        } else {
            XB_SPIN(xb_ld(&bar[XB_XGEN(b.x)]) == gen, bar);
            __builtin_amdgcn_fence(__ATOMIC_ACQUIRE, "agent");
            asm volatile("s_waitcnt vmcnt(0)" ::: "memory");
        }
    }
    __syncthreads();
}


constexpr size_t MiB = 1u << 20;
constexpr size_t WS_BAR = 0;
constexpr size_t WS_PCNT = 16 * 1024;
constexpr size_t WS_MOD = 64 * 1024;
constexpr size_t WS_BIASIN = 160 * 1024;
constexpr size_t WS_BIASGU = 192 * 1024;
constexpr size_t WS_ROPEC = 288 * 1024;
constexpr size_t WS_ROPES = 304 * 1024;
constexpr size_t WS_MREF = 328 * 1024;
constexpr size_t WS_KMAX = 332 * 1024;
constexpr size_t WS_ROWSS = 384 * 1024;
constexpr size_t WS_SWB = 320 * 1024;
constexpr size_t WS_WIN = 368 * MiB;
constexpr size_t WS_WO = 9 * MiB;
constexpr size_t WS_WGU = 384 * MiB;
constexpr size_t WS_WDN = 35 * MiB;
constexpr size_t WS_GSS = 46 * MiB;
constexpr size_t WS_H = 48 * MiB;
constexpr size_t WS_QKV = 112 * MiB;
constexpr size_t WS_Y = 240 * MiB;
constexpr size_t WS_ACT = 112 * MiB;
constexpr size_t WS_XA = 304 * MiB;
constexpr size_t WS_END = 428 * MiB;

constexpr int LDS_BYTES = 135168;

__device__ __forceinline__ float wave_sum(float v) {
#pragma unroll
    for (int o = 1; o < 64; o <<= 1) v += __shfl_xor(v, o);
    return v;
}

__device__ __forceinline__ int permf(int i) { return 16 * ((i >> 2) & 1) + 4 * (i >> 3) + (i & 3); }
__device__ __forceinline__ void tr_item(const float* W, int K, int N, int k0, int sc0, bool perm, bf16* WT, int dr0, LAS float* scr, int lane, const float* ksc = nullptr) {
#pragma unroll 8
    for (int i = 0; i < 32; ++i) { const int kk = 2 * i + (lane >> 5); scr[kk * 33 + (lane & 31)] = W[(size_t)(k0 + kk) * N + sc0 + (lane & 31)]; }
    asm volatile("s_waitcnt lgkmcnt(0)" ::: "memory");
    const int c = lane & 7;
    float kq[8];
#pragma unroll
    for (int e = 0; e < 8; ++e) kq[e] = ksc ? ksc[k0 + 8 * c + e] : 1.0f;
#pragma unroll
    for (int j = 0; j < 4; ++j) { const int n = (lane >> 3) + 8 * j; const int ci = perm ? permf(n) : n; const LAS float* s = scr + (8 * c) * 33 + ci;
        v4u o; o.x = pk_bf16(s[0 * 33] * kq[0], s[1 * 33] * kq[1]); o.y = pk_bf16(s[2 * 33] * kq[2], s[3 * 33] * kq[3]); o.z = pk_bf16(s[4 * 33] * kq[4], s[5 * 33] * kq[5]); o.w = pk_bf16(s[6 * 33] * kq[6], s[7 * 33] * kq[7]);
        *(v4u*)(WT + (size_t)(dr0 + n) * K + k0 + 8 * c) = o; }
    asm volatile("s_waitcnt lgkmcnt(0)" ::: "memory");
}
__device__ __forceinline__ void tr_item_ada(const float* W, int K, int N, int k0, int sc0, bool perm, bf16* WT0, bf16* WT1, int dr0, LAS float* scr, int lane,
                                            const float* g, const float* scA, const float* scB, const float* shA, const float* shB, float* biasA, float* biasB) {
#pragma unroll 8
    for (int i = 0; i < 32; ++i) { const int kk = 2 * i + (lane >> 5); scr[kk * 33 + (lane & 31)] = W[(size_t)(k0 + kk) * N + sc0 + (lane & 31)]; }
    asm volatile("s_waitcnt lgkmcnt(0)" ::: "memory");
    const int c = lane & 7;
    float qa[8], qb[8];
#pragma unroll
    for (int e = 0; e < 8; ++e) { const int k = k0 + 8 * c + e; const float gk = g[k]; qa[e] = gk * (1.0f + scA[k]); qb[e] = gk * (1.0f + scB[k]); }
#pragma unroll
    for (int j = 0; j < 4; ++j) { const int n = (lane >> 3) + 8 * j; const int ci = perm ? permf(n) : n; const LAS float* s = scr + (8 * c) * 33 + ci;
        float t[8];
#pragma unroll
        for (int e = 0; e < 8; ++e) t[e] = s[e * 33];
        v4u o; o.x = pg8::pk_f16(t[0] * qa[0], t[1] * qa[1]); o.y = pg8::pk_f16(t[2] * qa[2], t[3] * qa[3]); o.z = pg8::pk_f16(t[4] * qa[4], t[5] * qa[5]); o.w = pg8::pk_f16(t[6] * qa[6], t[7] * qa[7]);
        *(v4u*)(WT0 + (size_t)(dr0 + n) * K + k0 + 8 * c) = o;
        v4u p; p.x = pg8::pk_f16(t[0] * qb[0], t[1] * qb[1]); p.y = pg8::pk_f16(t[2] * qb[2], t[3] * qb[3]); p.z = pg8::pk_f16(t[4] * qb[4], t[5] * qb[5]); p.w = pg8::pk_f16(t[6] * qb[6], t[7] * qb[7]);
        *(v4u*)(WT1 + (size_t)(dr0 + n) * K + k0 + 8 * c) = p; }
    { const int n32 = lane & 31, hf = lane >> 5; const int cb = perm ? permf(n32) : n32;
      float bA = 0.f, bB = 0.f;
#pragma unroll 8
      for (int kk = 0; kk < 32; ++kk) { const int k = hf * 32 + kk; const float w = scr[k * 33 + cb]; bA += shA[k0 + k] * w; bB += shB[k0 + k] * w; }
      bA += __shfl_xor(bA, 32); bB += __shfl_xor(bB, 32);
      if (hf == 0) { atomicAdd(biasA + dr0 + n32, bA); atomicAdd(biasB + dr0 + n32, bB); } }
    asm volatile("s_waitcnt lgkmcnt(0)" ::: "memory");
}
__device__ __forceinline__ void win_src(int n0, int& sc0, bool& perm) {
    const int tile = n0 >> 8, bj = (n0 >> 7) & 1, w = n0 & 127;
    if (tile < 5 || (tile == 5 && bj == 0)) { sc0 = n0; perm = false; }
    else if (tile == 5) { sc0 = 1920 + w; perm = false; }
    else { const int s = w >> 5; const int hb = (tile == 6) ? 1408 + 64 * s : (s < 2 ? 1408 + 64 * (4 + s) : 1792 + 64 * (s - 2)); sc0 = hb + 32 * bj; perm = true; }
}

struct Args { const float* in[17]; float* out; unsigned char* ws; int ph_lo, ph_hi; };
enum { I_X = 0, I_C, I_WMOD, I_BMOD, I_GATTN, I_WIN, I_RPB, I_SINK, I_T5, I_GQ, I_GK, I_GGROUP, I_WO, I_GFFN, I_WGU, I_WDOWN, I_GFINAL };

__device__ __forceinline__ void phase_prep(const Args& a, LAS unsigned char* lds, int tid, int lane, int wave) {
    unsigned char* ws = a.ws;
    const int G = gridDim.x;
    for (int it = blockIdx.x; it < 192; it += G) {
        const int l = it / 96, j0 = (it % 96) * 64;
        const float* W = a.in[I_WMOD] + (size_t)l * 1024 * 6144 + j0 + lane;
        const float* c0 = a.in[I_C]; const float* c1 = c0 + 1024;
        float a0 = 0.f, a1 = 0.f;
        const int kb = wave * 128;
#pragma unroll 32
        for (int k = 0; k < 128; ++k) {
            const float w = W[(size_t)(kb + k) * 6144];
            const float x0 = c0[kb + k], x1 = c1[kb + k];
            a0 += w * (x0 / (1.0f + __expf(-x0))); a1 += w * (x1 / (1.0f + __expf(-x1)));
        }
        LAS float* red = (LAS float*)lds;
        red[(wave * 2 + 0) * 64 + lane] = a0; red[(wave * 2 + 1) * 64 + lane] = a1;
        __syncthreads();
        if (wave < 2) { float s = 0.f;
#pragma unroll
            for (int w8 = 0; w8 < 8; ++w8) s += red[(w8 * 2 + wave) * 64 + lane];
            s += a.in[I_BMOD][l * 6144 + j0 + lane];
            ((float*)(ws + WS_MOD))[(size_t)(l * 2 + wave) * 6144 + j0 + lane] = s; }
        __syncthreads();
    }
    for (int i = blockIdx.x * 512 + tid + MT / 4; i < 5 * MT / 4; i += G * 512) ((f32x4*)(ws + WS_ROWSS))[i] = (f32x4){0.f, 0.f, 0.f, 0.f};
    for (int i = blockIdx.x * 512 + tid; i < 6 * MT / 4; i += G * 512) ((f32x4*)(ws + WS_GSS))[i] = (f32x4){0.f, 0.f, 0.f, 0.f};
    for (int i = blockIdx.x * 512 + tid; i < (120 * 1024) / 16; i += G * 512) ((f32x4*)(ws + WS_BIASIN))[i] = (f32x4){0.f, 0.f, 0.f, 0.f};
    const int gt = blockIdx.x * 512 + tid;
    if (gt < 4096) { const int pos = gt >> 4, f = gt & 15; const float fr = exp2f(-(float)f * (13.287712379549449f / 16.0f)); const float ang = (float)pos * fr;
        ((float*)(ws + WS_ROPEC))[gt] = cosf(ang); ((float*)(ws + WS_ROPES))[gt] = sinf(ang); }
    if (gt >= 4096 && gt < 4096 + 6 * 257) { const int e = gt - 4096, h = e / 257, r = e % 257; const int rel = r - 128; const int n = rel < 0 ? -rel : rel;
        int bk = rel > 0 ? 16 : 0; int lg = n < 8 ? n : 8 + ((31 - __builtin_clz((unsigned)(n * n))) - 6); if (lg > 15) lg = 15; bk += lg;
        ((float*)(ws + WS_SWB))[h * 260 + r] = a.in[I_T5][bk * 6 + h] * LOG2E_; }
    if (gt >= 5900 && gt < 5900 + 32) ((unsigned*)(ws + WS_KMAX))[gt - 5900] = 0u;
    if (gt >= 5800 && gt < 5800 + DEPTH_) { const int l = gt - 5800; float gqm = 0.f, gkm = 0.f;
        for (int i = 0; i < 64; ++i) { gqm = fmaxf(gqm, fabsf(a.in[I_GQ][l * 64 + i])); gkm = fmaxf(gkm, fabsf(a.in[I_GK][l * 64 + i])); }
        ((float*)(ws + WS_MREF))[l] = fminf(8.0f * gqm * gkm * LOG2E_ * 1.02f, 100.0f); }
    { const int gw = blockIdx.x * 8 + wave, NGW = G * 8;
      const float* x = a.in[I_X]; float* rowss = (float*)(ws + WS_ROWSS);
      for (int blk = gw; blk < MT / 16; blk += NGW) {
        const int r0 = blk * 16;
#pragma unroll 2
        for (int r = 0; r < 16; ++r) {
            const f32x4* xr = (const f32x4*)(x + (size_t)(r0 + r) * 1024) + lane;
            f32x4 v[4]; float s_ = 0.f;
#pragma unroll
            for (int j = 0; j < 4; ++j) { v[j] = xr[64 * j]; s_ += (v[j][0] * v[j][0] + v[j][1] * v[j][1]) + (v[j][2] * v[j][2] + v[j][3] * v[j][3]); }
            s_ = wave_sum(s_);
            if (lane == 0) rowss[r0 + r] = s_;
            v2u* x8 = (v2u*)((bf16*)(ws + WS_H) + (size_t)(r0 + r) * 1024) + lane;
#pragma unroll
            for (int j = 0; j < 4; ++j) { v2u wx; wx.x = pg8::pk_f16(v[j][0], v[j][1]); wx.y = pg8::pk_f16(v[j][2], v[j][3]); x8[64 * j] = wx; }
        }
      } }
}

__device__ __forceinline__ void phase_p1(const Args& a, LAS unsigned char* lds, int lane, int wave) {
    unsigned char* ws = a.ws;
    const float* mod = (const float*)(ws + WS_MOD);
    LAS float* scr = (LAS float*)(lds + wave * 16384);
    const int gw = blockIdx.x * 8 + wave, NGW = gridDim.x * 8;
    constexpr int IT_IN = 16 * 64, IT_O = 16 * 32, IT_GU = 16 * 176, IT_DN = 44 * 32, IT_L = IT_IN + IT_O + IT_GU + IT_DN;
    for (int it = gw; it < 2 * IT_L; it += NGW) {
        const int l = it / IT_L; int r = it % IT_L;
        const float* md = mod + (size_t)l * 2 * 6144;
        if (r < IT_IN) { const int kb = r >> 6, nb = r & 63; int sc0; bool perm; win_src(nb * 32, sc0, perm);
            bf16* wt = (bf16*)(ws + WS_WIN) + (size_t)l * 2 * 2048 * 1024;
            tr_item_ada(a.in[I_WIN] + (size_t)l * 1024 * 2048, 1024, 2048, kb * 64, sc0, perm, wt, wt + (size_t)2048 * 1024, nb * 32, scr, lane,
                        a.in[I_GATTN] + l * 1024, md + 1024, md + 6144 + 1024, md, md + 6144, (float*)(ws + WS_BIASIN) + (size_t)l * 2 * 2048, (float*)(ws + WS_BIASIN) + (size_t)l * 2 * 2048 + 2048); continue; }
        r -= IT_IN;
        if (r < IT_O) { const int kb = r >> 5, nb = r & 31;
            tr_item(a.in[I_WO] + (size_t)l * 1024 * 1024, 1024, 1024, kb * 64, nb * 32, false, (bf16*)(ws + WS_WO) + (size_t)l * 1024 * 1024, nb * 32, scr, lane, a.in[I_GGROUP] + l * 1024); continue; }
        r -= IT_O;
        if (r < IT_GU) { const int kb = r / 176, nb = r % 176; const int n0 = nb * 32; const int sc0 = ((n0 >> 7) & 1) * 2816 + (n0 >> 8) * 128 + (n0 & 127);
            bf16* wt = (bf16*)(ws + WS_WGU) + (size_t)l * 2 * 5632 * 1024;
            tr_item_ada(a.in[I_WGU] + (size_t)l * 1024 * 5632, 1024, 5632, kb * 64, sc0, false, wt, wt + (size_t)5632 * 1024, n0, scr, lane,
                        a.in[I_GFFN] + l * 1024, md + 4096, md + 6144 + 4096, md + 3072, md + 6144 + 3072, (float*)(ws + WS_BIASGU) + (size_t)l * 2 * 5632, (float*)(ws + WS_BIASGU) + (size_t)l * 2 * 5632 + 5632); continue; }
        r -= IT_GU;
        { const int kb = r >> 5, nb = r & 31;
            tr_item(a.in[I_WDOWN] + (size_t)l * 2816 * 1024, 2816, 1024, kb * 64, nb * 32, false, (bf16*)(ws + WS_WDN) + (size_t)l * 1024 * 2816, nb * 32, scr, lane); }
    }
}
__device__ __forceinline__ void phase_final(const bf16* xb, float* out, const float* g, const float* rowss, int lane, int wave) {
    const int gw = blockIdx.x * 8 + wave, NGW = gridDim.x * 8;
    f32x4 gv[4];
#pragma unroll
    for (int j = 0; j < 4; ++j) gv[j] = *(const f32x4*)(g + 16 * lane + 4 * j);
    for (int row = gw; row < MT; row += NGW) {
        const v4u* xr = (const v4u*)(xb + (size_t)row * 1024 + 16 * lane);
        const v4u w0 = xr[0], w1 = xr[1];
        const float rinv = rsqrtf(rowss[row] * (1.0f / 1024.0f) + EPS_);
        f32x4* o = (f32x4*)(out + (size_t)row * 1024 + 16 * lane);
        { const pg8::f32x2 a0 = pg8::up_f16(w0.x), a1 = pg8::up_f16(w0.y), a2 = pg8::up_f16(w0.z), a3 = pg8::up_f16(w0.w);
          const pg8::f32x2 b0 = pg8::up_f16(w1.x), b1 = pg8::up_f16(w1.y), b2 = pg8::up_f16(w1.z), b3 = pg8::up_f16(w1.w);
          o[0] = (f32x4){a0[0], a0[1], a1[0], a1[1]} * rinv * gv[0]; o[1] = (f32x4){a2[0], a2[1], a3[0], a3[1]} * rinv * gv[1];
          o[2] = (f32x4){b0[0], b0[1], b1[0], b1[1]} * rinv * gv[2]; o[3] = (f32x4){b2[0], b2[1], b3[0], b3[1]} * rinv * gv[3]; }
    }
}
__device__ __forceinline__ float bf_lo(unsigned w) { return __uint_as_float(w << 16); }
__device__ __forceinline__ float bf_hi(unsigned w) { return __uint_as_float(w & 0xffff0000u); }
__device__ __forceinline__ void phase_gnorm(const bf16* y, const float* gg, bf16* yn, int lane, int wave) {
    const int gw = blockIdx.x * 8 + wave, NGW = gridDim.x * 8;
    float gv[16];
#pragma unroll
    for (int j = 0; j < 4; ++j) { const f32x4 t = *(const f32x4*)(gg + 16 * lane + 4 * j); gv[4 * j] = t[0]; gv[4 * j + 1] = t[1]; gv[4 * j + 2] = t[2]; gv[4 * j + 3] = t[3]; }
    const int grp = lane < 16 ? 0 : (lane < 40 ? 1 : 2);
    for (int row = gw; row < MT; row += NGW) {
        const v4u* yr = (const v4u*)(y + (size_t)row * 1024 + 16 * lane);
        const v4u w0 = yr[0], w1 = yr[1];
        float v[16];
        v[0] = bf_lo(w0.x); v[1] = bf_hi(w0.x); v[2] = bf_lo(w0.y); v[3] = bf_hi(w0.y); v[4] = bf_lo(w0.z); v[5] = bf_hi(w0.z); v[6] = bf_lo(w0.w); v[7] = bf_hi(w0.w);
        v[8] = bf_lo(w1.x); v[9] = bf_hi(w1.x); v[10] = bf_lo(w1.y); v[11] = bf_hi(w1.y); v[12] = bf_lo(w1.z); v[13] = bf_hi(w1.z); v[14] = bf_lo(w1.w); v[15] = bf_hi(w1.w);
        float s = 0.f;
#pragma unroll
        for (int j = 0; j < 16; ++j) s += v[j] * v[j];
        const float sA = wave_sum(grp == 0 ? s : 0.f), sB = wave_sum(grp == 1 ? s : 0.f), sC = wave_sum(grp == 2 ? s : 0.f);
        const float rinv = grp == 0 ? rsqrtf(sA * (1.0f / 256.0f) + EPS_) : (grp == 1 ? rsqrtf(sB * (1.0f / 384.0f) + EPS_) : rsqrtf(sC * (1.0f / 384.0f) + EPS_));
        v4u o0, o1;
        o0.x = pk_bf16(v[0] * rinv * gv[0], v[1] * rinv * gv[1]); o0.y = pk_bf16(v[2] * rinv * gv[2], v[3] * rinv * gv[3]);
        o0.z = pk_bf16(v[4] * rinv * gv[4], v[5] * rinv * gv[5]); o0.w = pk_bf16(v[6] * rinv * gv[6], v[7] * rinv * gv[7]);
        o1.x = pk_bf16(v[8] * rinv * gv[8], v[9] * rinv * gv[9]); o1.y = pk_bf16(v[10] * rinv * gv[10], v[11] * rinv * gv[11]);
        o1.z = pk_bf16(v[12] * rinv * gv[12], v[13] * rinv * gv[13]); o1.w = pk_bf16(v[14] * rinv * gv[14], v[15] * rinv * gv[15]);
        v4u* orow = (v4u*)(yn + (size_t)row * 1024 + 16 * lane);
        orow[0] = o0; orow[1] = o1;
    }
}

__device__ __forceinline__ int crow16(int i, int hi) { return (i & 3) + 8 * (i >> 2) + 4 * hi; }
template <int MODE>
__device__ __forceinline__ void small_attn_wave(const bf16* Qb, int qpitch, const bf16* Kp, const bf16* Vp, int kvpitch, bf16* Ob,
                                                int qt  , int qcol0, const float* gtab, int ntab, float tabscale, float sink2,
                                                float* gssrow, const unsigned* kmax2, LAS unsigned char* wl, int lane) {
    const int r32 = lane & 31, hi = lane >> 5;
    LAS float* tab = (LAS float*)(wl + 9216);
    const int qrow = qt + (r32 >> 4), qc = qcol0 + (r32 & 15);
    const int qtok = MODE == 0 ? qt + r32 : qrow * 64 + qc;
    bf16x8 qf[4];
#pragma unroll
    for (int ks = 0; ks < 4; ++ks) qf[ks] = *(const bf16x8*)(Qb + (size_t)qtok * qpitch + 16 * ks + 8 * hi);
    int nt, tb0, tstep, rsA = 0, kc0 = 0, my_rs = 0, my_cs = 0;
    if (MODE == 0) { const int t0 = qt - 128 < 0 ? 0 : qt - 128; const int t1 = qt + 160 > SEQ_ ? SEQ_ : qt + 160; tb0 = t0; nt = (t1 - t0) >> 5; tstep = 32; }
    else { rsA = qt - 4; rsA = rsA < 0 ? 0 : (rsA > 248 ? 248 : rsA); int rsB = qt - 3; rsB = rsB < 0 ? 0 : (rsB > 248 ? 248 : rsB); nt = 8 + (rsB - rsA);
        kc0 = qcol0 - 8; kc0 = kc0 < 0 ? 0 : (kc0 > 32 ? 32 : kc0); tb0 = rsA * 64 + kc0; tstep = 64;
        my_rs = qrow - 4; my_rs = my_rs < 0 ? 0 : (my_rs > 248 ? 248 : my_rs); my_cs = qc - 8; my_cs = my_cs < 0 ? 0 : (my_cs > 48 ? 48 : my_cs); }
    bf16x8 kf[4]; v4u vr[4];
#define SA_LOAD(tbase) do { const bf16* kp_ = Kp + (size_t)((tbase) + r32) * kvpitch + 8 * hi; \
        _Pragma("unroll") for (int ks = 0; ks < 4; ++ks) kf[ks] = *(const bf16x8*)(kp_ + 16 * ks); \
        _Pragma("unroll") for (int e = 0; e < 4; ++e) { const int c = lane + 64 * e; vr[e] = *(const v4u*)(Vp + (size_t)((tbase) + (c >> 3)) * kvpitch + (c & 7) * 8); } } while (0)
#define SA_VWRITE(buf) do { _Pragma("unroll") for (int e = 0; e < 4; ++e) { const int c = lane + 64 * e; *(LAS v4u*)(wl + (buf) * 4608 + (c >> 3) * 144 + (c & 7) * 16) = vr[e]; } } while (0)
#define SA_QK(X) do { _Pragma("unroll") for (int ks = 0; ks < 4; ++ks) X = __builtin_amdgcn_mfma_f32_32x32x16_bf16(kf[ks], qf[ks], X, 0, 0, 0); } while (0)
#define SA_CINIT(ti, X) do { const int tbc = tb0 + tstep * (ti); \
        if (MODE == 0) { const int relb = tbc - qtok + 4 * hi; const int d = tbc - qt; \
            if (d >= -96 && d <= 96) { const LAS float* tp = tab + (relb + 128); \
                _Pragma("unroll") for (int e = 0; e < 16; ++e) X[e] = tp[(e & 3) + 8 * (e >> 2)]; \
            } else { \
                _Pragma("unroll") for (int e = 0; e < 16; ++e) { const int rel = relb + (e & 3) + 8 * (e >> 2); const bool ok = (unsigned)(rel + 128) <= 256u; \
                    const int idx = ok ? rel + 128 : 0; X[e] = ok ? tab[idx] : -1e30f; } } \
        } else { \
            const int kr = rsA + (ti); const bool rowok = (unsigned)(kr - my_rs) < 8u; const int colb = kc0 + 4 * hi - my_cs; \
            int ib = (kr - qrow + 7) * 31 + kc0 + 4 * hi - qc + 15; ib = rowok ? ib : 0; \
            _Pragma("unroll") for (int e = 0; e < 16; ++e) { const int cc = (e & 3) + 8 * (e >> 2); const bool ok = rowok && ((unsigned)(colb + cc) < 16u); \
                const int idx = ok ? ib + cc : 0; X[e] = ok ? tab[idx] : -1e30f; } \
        } } while (0)
    SA_LOAD(tb0);
    float bmx = -1e30f;
    for (int e = lane; e < ntab; e += 64) { const float tv_ = gtab[e] * tabscale; tab[e] = tv_; bmx = fmaxf(bmx, tv_); }
#pragma unroll
    for (int o_ = 1; o_ < 64; o_ <<= 1) bmx = fmaxf(bmx, __shfl_xor(bmx, o_));
    float ref;
    { float qs = 0.f;
#pragma unroll
      for (int ks = 0; ks < 4; ++ks) { const v4u qw = __builtin_bit_cast(v4u, qf[ks]);
#pragma unroll
          for (int e = 0; e < 4; ++e) { const float lo_ = __uint_as_float(qw[e] << 16), hi_ = __uint_as_float(qw[e] & 0xffff0000u); qs += lo_ * lo_ + hi_ * hi_; } }
      auto rr = __builtin_amdgcn_permlane32_swap(__float_as_uint(qs), __float_as_uint(qs), false, false); qs = __uint_as_float(rr[0]) + __uint_as_float(rr[1]);
      const float k2 = __uint_as_float(kmax2[0]) + __uint_as_float(kmax2[1]);
      ref = fminf(__builtin_sqrtf(qs * k2) * 1.03f + bmx, 110.0f); }
    f32x16 o0 = {}, o1 = {};
    float lsum = 0.f;
    const int i16 = lane & 15, g16 = (lane >> 4) & 1;
    LAS unsigned char* vaddr = wl + (4 * hi + (i16 >> 2)) * 144 + g16 * 32 + 8 * (i16 & 3);
    f32x16 xa_, xb_;
    SA_VWRITE(0); SA_CINIT(0, xa_); SA_QK(xa_);
    if (nt > 1) SA_LOAD(tb0 + tstep);
#define SA_TILE(i, X, XN) do { \
        const int tb = tb0 + tstep * (i); \
        if ((i) + 1 < nt) { SA_VWRITE(((i) + 1) & 1); SA_CINIT((i) + 1, XN); SA_QK(XN); if ((i) + 2 < nt) SA_LOAD(tb + 2 * tstep); } \
        float ps = 0.f; \
        _Pragma("unroll") for (int e = 0; e < 16; ++e) { const float p_ = __builtin_amdgcn_exp2f(X[e] - ref); X[e] = p_; ps += p_; } \
        lsum += ps; \
        v4u pw0, pw1; \
        pw0.x = pk_bf16(X[0], X[1]); pw0.y = pk_bf16(X[2], X[3]); pw0.z = pk_bf16(X[4], X[5]); pw0.w = pk_bf16(X[6], X[7]); \
        pw1.x = pk_bf16(X[8], X[9]); pw1.y = pk_bf16(X[10], X[11]); pw1.z = pk_bf16(X[12], X[13]); pw1.w = pk_bf16(X[14], X[15]); \
        const bf16x8 pb0 = __builtin_bit_cast(bf16x8, pw0), pb1 = __builtin_bit_cast(bf16x8, pw1); \
        asm volatile("s_waitcnt lgkmcnt(0)" ::: "memory"); \
        LAS unsigned char* va_ = vaddr + ((i) & 1) * 4608; \
        { const s16x4 a0 = TRR(va_, 0), a1 = TRR(va_, 8 * 144), b0 = TRR(va_, 16 * 144), b1 = TRR(va_, 24 * 144); \
          o0 = __builtin_amdgcn_mfma_f32_32x32x16_bf16(CAT(a0, a1), pb0, o0, 0, 0, 0); \
          o0 = __builtin_amdgcn_mfma_f32_32x32x16_bf16(CAT(b0, b1), pb1, o0, 0, 0, 0); } \
        { const s16x4 a0 = TRR(va_, 64), a1 = TRR(va_, 64 + 8 * 144), b0 = TRR(va_, 64 + 16 * 144), b1 = TRR(va_, 64 + 24 * 144); \
          o1 = __builtin_amdgcn_mfma_f32_32x32x16_bf16(CAT(a0, a1), pb0, o1, 0, 0, 0); \
          o1 = __builtin_amdgcn_mfma_f32_32x32x16_bf16(CAT(b0, b1), pb1, o1, 0, 0, 0); } \
        asm volatile("s_waitcnt lgkmcnt(0)" ::: "memory"); \
    } while (0)
    typedef short v4i16_t __attribute__((ext_vector_type(4)));
#define TRR(base, off) __builtin_bit_cast(s16x4, __builtin_amdgcn_ds_read_tr16_b64_v4i16((LAS v4i16_t*)((base) + (off))))
#define CAT(a, b) (bf16x8){a[0], a[1], a[2], a[3], b[0], b[1], b[2], b[3]}
    for (int i = 0; i < nt; i += 2) {
        SA_TILE(i, xa_, xb_);
        if (i + 1 < nt) SA_TILE(i + 1, xb_, xa_);
    }
#undef TRR
#undef CAT
#undef SA_TILE
#undef SA_QK
#undef SA_CINIT
#undef SA_VWRITE
#undef SA_LOAD
    { auto rr = __builtin_amdgcn_permlane32_swap(__float_as_uint(lsum), __float_as_uint(lsum), false, false); lsum = __uint_as_float(rr[0]) + __uint_as_float(rr[1]); }
    if (MODE == 0) lsum += __builtin_amdgcn_exp2f(sink2 - ref);
    const float inv = 1.0f / lsum;
    { float ss = 0.f;
#pragma unroll
      for (int e = 0; e < 16; ++e) { const float a0 = o0[e] * inv, a1 = o1[e] * inv; ss += a0 * a0 + a1 * a1; }
      auto rr = __builtin_amdgcn_permlane32_swap(__float_as_uint(ss), __float_as_uint(ss), false, false); ss = __uint_as_float(rr[0]) + __uint_as_float(rr[1]);
      if (hi == 0) atomicAdd(gssrow + qtok, ss); }
    bf16* orow = Ob + (size_t)qtok * 1024 + 4 * hi;
#pragma unroll
    for (int gq = 0; gq < 4; ++gq) {
        v2u w; w.x = pk_bf16(o0[4 * gq] * inv, o0[4 * gq + 1] * inv); w.y = pk_bf16(o0[4 * gq + 2] * inv, o0[4 * gq + 3] * inv); *(v2u*)(orow + 8 * gq) = w;
        v2u w2; w2.x = pk_bf16(o1[4 * gq] * inv, o1[4 * gq + 1] * inv); w2.y = pk_bf16(o1[4 * gq + 2] * inv, o1[4 * gq + 3] * inv); *(v2u*)(orow + 32 + 8 * gq) = w2;
    }
}

#ifndef PROBE_SYNC
#define PROBE_SYNC 0
#endif
#ifndef PROBE_MISC
#define PROBE_MISC 0
#endif
#ifndef PROBE_GU
#define PROBE_GU 0
#endif
#ifndef PROBE_DENSE
#define PROBE_DENSE 1
#endif
#ifndef PROBE_SMALL
#define PROBE_SMALL 1
#endif
__global__ void __launch_bounds__(512) mega_fwd(Args args) {
    extern __shared__ __attribute__((aligned(16))) unsigned char lds_raw[];
    LAS unsigned char* lds = (LAS unsigned char*)lds_raw;
    cg::grid_group grid = cg::this_grid();
    volatile LAS unsigned* MISC = (volatile LAS unsigned*)(lds + 131072);
    if (threadIdx.x < 16) MISC[threadIdx.x] = 0u;
    __syncthreads();
    XcdBarrier xbar = xcd_barrier_post((unsigned*)(args.ws + WS_BAR), MISC + 8);
#define FRESH() int t_ = threadIdx.x; asm volatile("" : "+v"(t_)); const int tid = t_, lane = t_ & 63, wave = __builtin_amdgcn_readfirstlane(t_ >> 6); (void)tid; (void)lane; (void)wave
    const int G = gridDim.x;
    unsigned char* ws = args.ws;
    const int lo = args.ph_lo, hi = args.ph_hi;
    float* xres = args.out;
    const float* modp = (const float*)(ws + WS_MOD);
    bf16* HB = (bf16*)(ws + WS_H);     bf16* QKV = (bf16*)(ws + WS_QKV); bf16* YB = (bf16*)(ws + WS_Y); bf16* ACT = (bf16*)(ws + WS_ACT);
    int ph = 0;
#define IN_(k) (lo <= (k) && (k) < hi)
#define SEAM(k) do { if (IN_(k) && IN_((k) + 1)) { if (args.ph_lo < 0) grid.sync();   xcd_barrier(xbar); for (int e_ = 0; e_ < PROBE_SYNC; ++e_) xcd_barrier(xbar); } } while (0)

    if (IN_(ph)) { FRESH(); phase_prep(args, lds, tid, lane, wave);
#if PROBE_MISC
        __syncthreads(); phase_prep(args, lds, tid, lane, wave);
#endif
    }
    SEAM(ph); ++ph;
    if (IN_(ph)) { FRESH(); phase_p1(args, lds, lane, wave);
#if PROBE_MISC
        phase_p1(args, lds, lane, wave);
#endif
    }
    SEAM(ph); ++ph;
    float* ROWSS = (float*)(ws + WS_ROWSS); float* GSS = (float*)(ws + WS_GSS);

    for (int l = 0; l < DEPTH_; ++l) {
        const float* mod_l = modp + (size_t)l * 2 * 6144;
        const float* xin = (l == 0) ? args.in[I_X] : xres;
        if (IN_(ph)) {
            pg8::Gemm g{HB, (const bf16*)(ws + WS_WIN) + (size_t)l * 2 * 2048 * 1024, MT, INW, 1024, (size_t)2048 * 1024 * 2, 64};     pg8::StaticOrder S; S.init(MT, INW, G, (int)blockIdx.x, 1);
            pg8::EpiInProj E{QKV, (const float*)(ws + WS_ROPEC), (const float*)(ws + WS_ROPES), args.in[I_GQ] + l * 64, args.in[I_GK] + l * 64, ROWSS + (size_t)(2 * l) * MT, (const float*)(ws + WS_BIASIN) + (size_t)l * 2 * 2048, (unsigned*)(ws + WS_KMAX) + (size_t)l * 16};
            pg8::gemm_phase<pg8::EpiInProj, pg8::StaticOrder, true, true, true>(lds, g, S, E);
        }
        SEAM(ph); ++ph;
        if (IN_(ph)) {
            for (int rep = 0; rep < PROBE_DENSE; ++rep)
            for (int ui = 0, u = blockIdx.x; u < 768; u += G, ++ui) {
                int qb = u & 63, h3 = (u >> 6) % 3, kvh = (u / 192) & 1, b = u / 384;
                if (G == 256) { const int xcd = blockIdx.x & 7, j = blockIdx.x >> 3;
                    b = (xcd >> 1) & 1; kvh = xcd & 1; h3 = ui; qb = (xcd >> 2) * 32 + j; }
                attn_body::attn_unit<8>(b, kvh * 3 + h3, qb, (const attn_body::bf16*)(QKV + pg8::OFF_QC), (const attn_body::bf16*)(QKV + pg8::OFF_KC),
                                        (const attn_body::bf16*)(QKV + pg8::OFF_VC), (attn_body::bf16*)(YB + 640), GSS + (size_t)(l * 3 + 2) * MT, ((const float*)(ws + WS_MREF))[l], (char*)lds_raw);
            }
            __syncthreads();
            FRESH();
            LAS unsigned char* wl = lds + wave * 11264;
            for (int uu = blockIdx.x; uu < 768 * PROBE_SMALL; uu += G) {
                const int u = uu % 768; const int qb = u & 63, h = (u >> 6) % 6, b = u / 384; const int qt = qb * 256 + wave * 32; const size_t rb = (size_t)b * SEQ_;
                small_attn_wave<0>(QKV + pg8::OFF_QB + rb * 384 + h * 64, 384, QKV + pg8::OFF_KB + rb * 128 + (h / 3) * 64, QKV + pg8::OFF_VB + rb * 128 + (h / 3) * 64, 128,
                                   YB + rb * 1024 + 256 + h * 64, qt, 0, (const float*)(ws + WS_SWB) + h * 260, 257, 1.0f, args.in[I_SINK][l * 6 + h] * LOG2E_, GSS + (size_t)(l * 3 + 1) * MT + rb, (const unsigned*)(ws + WS_KMAX) + ((l * 2 + 1) * 4 + h / 3) * 2, wl, lane);
            }
            for (int uu = blockIdx.x; uu < 512 * PROBE_SMALL; uu += G) {
                const int u = uu & 511; const int qb = u & 63, h = (u >> 6) & 3, b = u >> 8; const size_t rb = (size_t)b * SEQ_;
                small_attn_wave<1>(QKV + pg8::OFF_QA + rb * 256 + h * 64, 256, QKV + pg8::OFF_KA + rb * 256 + h * 64, QKV + pg8::OFF_VA + rb * 256 + h * 64, 256,
                                   YB + rb * 1024 + h * 64, qb * 4 + 2 * (wave >> 2), 16 * (wave & 3), args.in[I_RPB] + (size_t)(l * 4 + h) * 465, 465, LOG2E_, 0.f, GSS + (size_t)(l * 3 + 0) * MT + rb, (const unsigned*)(ws + WS_KMAX) + ((l * 2 + 0) * 4 + h) * 2, wl, lane);
            }
            __syncthreads();
        }
        SEAM(ph); ++ph;
        if (IN_(ph)) {
            pg8::Gemm g{YB, (const bf16*)(ws + WS_WO) + (size_t)l * 1024 * 1024, MT, 1024, 1024, 0, 1 << 30}; pg8::StaticOrder S; S.init(MT, 1024, G, (int)blockIdx.x);
            pg8::EpiResid<true> E{HB, HB, mod_l + 2048, 6144, ROWSS + (size_t)(2 * l + 1) * MT, nullptr, GSS + (size_t)(l * 3) * MT};
            pg8::gemm_phase<pg8::EpiResid<true>, pg8::StaticOrder, true, true>(lds, g, S, E);
        }
        SEAM(ph); ++ph;
        if (IN_(ph)) {
            pg8::Gemm g{HB, (const bf16*)(ws + WS_WGU) + (size_t)l * 2 * 5632 * 1024, MT, 5632, 1024, (size_t)5632 * 1024 * 2, 64}; pg8::StaticOrder S; S.init(MT, 5632, G, (int)blockIdx.x);
            pg8::EpiSwiGLU E{ACT, ROWSS + (size_t)(2 * l + 1) * MT, (const float*)(ws + WS_BIASGU) + (size_t)l * 2 * 5632};
            pg8::gemm_phase<pg8::EpiSwiGLU, pg8::StaticOrder, true, true, true>(lds, g, S, E);
#if PROBE_GU
            pg8::gemm_phase<pg8::EpiSwiGLU, pg8::StaticOrder, true, true, true>(lds, g, S, E);
#endif
        }
        SEAM(ph); ++ph;
        if (IN_(ph)) {
            pg8::Gemm g{ACT, (const bf16*)(ws + WS_WDN) + (size_t)l * 1024 * 2816, MT, 1024, 2816, 0, 1 << 30}; pg8::StaticOrder S; S.init(MT, 1024, G, (int)blockIdx.x);
            pg8::EpiResid<false> E{HB, HB, mod_l + 5120, 6144, ROWSS + (size_t)(2 * l + 2) * MT, (l + 1 < DEPTH_) ? (unsigned*)nullptr : (unsigned*)(ws + WS_PCNT), nullptr};
            pg8::gemm_phase<pg8::EpiResid<false>, pg8::StaticOrder, true, true>(lds, g, S, E);
            if (l + 1 == DEPTH_) {
                FRESH();
                const float* rs = ROWSS + (size_t)(2 * DEPTH_) * MT; unsigned* pc = (unsigned*)(ws + WS_PCNT);
                pg8::Unit u;
                for (int i = 0; S.next(i, u); ++i) {
                    if (tid == 0) { unsigned sp = 0; while (__hip_atomic_load(pc + 64 * u.pm, __ATOMIC_RELAXED, __HIP_MEMORY_SCOPE_AGENT) < 32u && ++sp < (1u << 22)) __builtin_amdgcn_s_sleep(2); }
                    __syncthreads();
                    __builtin_amdgcn_fence(__ATOMIC_ACQUIRE, "agent");
                    const f32x4 g4 = *(const f32x4*)(args.in[I_GFINAL] + u.pn * 256 + 4 * lane);
                    const float myrinv = rsqrtf(__hip_atomic_load(rs + u.pm * 256 + wave * 32 + (lane & 31), __ATOMIC_RELAXED, __HIP_MEMORY_SCOPE_AGENT) * (1.0f / 1024.0f) + EPS_);
#pragma unroll 8
                    for (int r = 0; r < 32; ++r) { const int row = u.pm * 256 + wave * 32 + r;
                        const float rinv = __shfl(myrinv, r);
                        const v2u q = *((const v2u*)(HB + (size_t)row * 1024 + u.pn * 256) + lane);
                        const pg8::f32x2 a0 = pg8::up_f16(q.x), a1 = pg8::up_f16(q.y);
                        *((f32x4*)(xres + (size_t)row * 1024 + u.pn * 256) + lane) = (f32x4){a0[0], a0[1], a1[0], a1[1]} * rinv * g4; }
                }
            }
        }
        SEAM(ph); ++ph;
    }
#undef IN_
#undef SEAM
}

constexpr int N_PHASES = 2 + 5 * DEPTH_;
#ifndef MK_PER_PHASE
#define MK_PER_PHASE 0
#endif

extern "C" void kernel_launch(void* const* d_in, const int* in_sizes, int n_in, void* d_out, int out_size, void* d_ws, size_t ws_size, hipStream_t stream) {
    static int grid = 0;
    if (grid == 0) {
        if (n_in != 17 || out_size != MT * DM || ws_size < WS_END) { fprintf(stderr, "kernel_launch: unexpected shapes (n_in %d out %d ws %zu)\n", n_in, out_size, ws_size); grid = -1; return; }
        int dev = 0, cus = 0, per_cu = 0;
        hipGetDevice(&dev); hipDeviceGetAttribute(&cus, hipDeviceAttributeMultiprocessorCount, dev);
        if (hipFuncSetAttribute((const void*)mega_fwd, hipFuncAttributeMaxDynamicSharedMemorySize, LDS_BYTES) != hipSuccess) { fprintf(stderr, "kernel_launch: hipFuncSetAttribute failed\n"); grid = -1; return; }
        if (hipOccupancyMaxActiveBlocksPerMultiprocessor(&per_cu, (const void*)mega_fwd, 512, LDS_BYTES) != hipSuccess || per_cu < 1) { fprintf(stderr, "kernel_launch: occupancy query says %d\n", per_cu); per_cu = 1; }
        (void)hipGetLastError();
        grid = cus * 1;
        fprintf(stderr, "kernel_launch: grid %d (cus %d, per_cu %d)\n", grid, cus, per_cu);
    }
    if (grid < 0) return;
    if (hipMemsetAsync((char*)d_ws + WS_BAR, 0, 65536, stream) != hipSuccess) { fprintf(stderr, "kernel_launch: memset failed\n"); return; }
    Args a{};
    for (int i = 0; i < 17; ++i) a.in[i] = (const float*)d_in[i];
    a.out = (float*)d_out; a.ws = (unsigned char*)d_ws;
#if MK_PER_PHASE
    for (int p = 0; p < N_PHASES; ++p) { a.ph_lo = p; a.ph_hi = p + 1; hipLaunchKernelGGL(mega_fwd, dim3(grid), dim3(512), LDS_BYTES, stream, a); }
#else
    a.ph_lo = 0; a.ph_hi = N_PHASES;
    void* kargs[] = {&a};
    hipError_t e = hipLaunchCooperativeKernel((const void*)mega_fwd, dim3(grid), dim3(512), kargs, LDS_BYTES, stream);
    if (e != hipSuccess) fprintf(stderr, "kernel_launch: cooperative launch failed: %s (grid %d)\n", hipGetErrorString(e), grid);
#endif
}
```

```cpp
#include <hip/hip_runtime.h>
#include <hip/hip_bf16.h>
#include <hip/hip_cooperative_groups.h>
#include <cstdio>
#include <cstdint>
#include <cmath>
namespace cg = cooperative_groups;

constexpr int DM = 1024, NB = 2, SEQ_ = 16384, MT = NB * SEQ_, DEPTH_ = 2, FFH = 2816, INW = 2048;
constexpr float EPS_ = 1e-6f;
constexpr float LOG2E_ = 1.4426950408889634f;

#ifndef PROBE_EPI
#define PROBE_EPI 0
#endif
namespace pg8 {
#define PG8_LAS __attribute__((address_space(3)))
typedef unsigned short bf16_t;
typedef short bf16x8 __attribute__((ext_vector_type(8)));
typedef float f32x4 __attribute__((ext_vector_type(4)));
typedef unsigned u32x4 __attribute__((ext_vector_type(4)));
constexpr int BM = 256, BK = 64, HALF = 128, HTB = HALF * BK * 2  , STAGE_BYTES = 8 * HTB, NXCD = 8, WGM = 4;

__host__ __device__ __forceinline__ int lds_byte(int r, int c) { const int st = (r >> 4) * 2 + (c >> 5), rr = r & 15, cc = c & 31, ob = rr * 64 + cc * 2; return st * 1024 + (ob ^ (((ob >> 9) & 1) << 5)); }
__host__ __device__ __forceinline__ void stage_rc(int b, int& R, int& C) { const int st = b / 1024, sb = b % 1024, swz = sb ^ (((sb >> 9) & 1) << 5); R = (st >> 1) * 16 + swz / 64; C = (st & 1) * 32 + (swz % 64) / 2; }
__host__ __device__ __forceinline__ int perm32(int rho) { const int n = rho >> 4, i = rho & 15; return 8 * (i >> 2) + 4 * n + (i & 3); }

struct Unit { int pm, pn; };
struct Gemm { const bf16_t* A; const bf16_t* Bt; int M, N, K; size_t bstride; int mhalf; };

struct StaticOrder {
    int nM, nN, nwg, G, c, swz;
    __host__ __device__ void init(int M, int N, int G_, int c_, int swz_ = 0) { nM = M / BM; nN = N / BM; nwg = nM * nN; G = G_; c = c_; swz = swz_; }
    __host__ __device__ bool next(int i, Unit& u) const {
        const long L = (long)i * G + c; if (L >= nwg) return false;
        int wgid = (int)L; { const int q = nwg / NXCD, r = nwg % NXCD, xcd = wgid % NXCD, off = wgid / NXCD; wgid = (xcd < r ? xcd * (q + 1) : r * (q + 1) + (xcd - r) * q) + off; }
        const int nig = WGM * nN, gid = wgid / nig, fm = gid * WGM, gsz = (nM - fm) < WGM ? (nM - fm) : WGM;
        u.pm = fm + ((wgid % nig) % gsz); u.pn = (wgid % nig) / gsz; if (swz) u.pn = (u.pn + 2 * ((u.pm >> 2) & 3)) & 7;     return true;
    }
    __device__ __forceinline__ void a_ready(const Unit&) const {}
    __device__ __forceinline__ void done(const Unit&) const {}
};

__device__ __forceinline__ unsigned cvt_pk_bf16(float lo, float hi) { unsigned r; asm volatile("v_cvt_pk_bf16_f32 %0, %1, %2" : "=v"(r) : "v"(lo), "v"(hi)); return r; }
typedef float f32x2 __attribute__((ext_vector_type(2)));

typedef __bf16 bf16x2_t __attribute__((ext_vector_type(2)));
__device__ __forceinline__ unsigned pk_bf16(float lo, float hi) { f32x2 v = {lo, hi}; bf16x2_t b = __builtin_convertvector(v, bf16x2_t); return __builtin_bit_cast(unsigned, b); }

typedef _Float16 f16x2_t __attribute__((ext_vector_type(2)));
__device__ __forceinline__ unsigned pk_f16(float lo, float hi) { f32x2 v = {lo, hi}; f16x2_t h = __builtin_convertvector(v, f16x2_t); return __builtin_bit_cast(unsigned, h); }
__device__ __forceinline__ f32x2 up_f16(unsigned w) { return __builtin_convertvector(__builtin_bit_cast(f16x2_t, w), f32x2); }
constexpr size_t QM = 32768;
constexpr size_t OFF_QA = 0, OFF_KA = QM * 256, OFF_VA = 2 * QM * 256, OFF_QB = 3 * QM * 256, OFF_KB = OFF_QB + QM * 384, OFF_VB = OFF_KB + QM * 128,
                 OFF_QC = OFF_VB + QM * 128, OFF_KC = OFF_QC + QM * 384, OFF_VC = OFF_KC + QM * 128;

struct EpiInProj {
    static constexpr bool PERM = true, AFTER_DRAIN = false, PROBE2 = false, KHOOK = false;
    bf16_t* qkv; const float* ropec; const float* ropes; const float* gq; const float* gk; const float* rowss; const float* bias; unsigned* kmax;
    __device__ __forceinline__ void operator()(const f32x4 (&acc)[2][2][4][2], const Unit& u, int wr, int wc, int fr, int fq) const {
        const int row0 = u.pm * BM + wr * 64 + fr; const int pn = u.pn;
        int fqo = fq; asm volatile("" : "+v"(fqo));
        const float* bp = bias + (size_t)((u.pm * BM) >> 14) * 2048 + pn * BM + wc * 32 + 8 * fqo;
        if (pn < 6) {
#pragma unroll
            for (int bj = 0; bj < 2; ++bj) {
                size_t off; int pitch, c0;
                if (pn < 3) { off = (size_t)pn * QM * 256; pitch = 256; c0 = bj * 128; }
                else if (pn == 3) { off = OFF_QB; pitch = 384; c0 = bj * 128; }
                else if (pn == 4) { if (bj == 0) { off = OFF_QB; pitch = 384; c0 = 256; } else { off = OFF_KB; pitch = 128; c0 = 0; } }
                else { off = bj == 0 ? OFF_VB : OFF_VC; pitch = 128; c0 = 0; }
                bf16_t* base = qkv + off + c0 + wc * 32 + 8 * fqo;
                const f32x4 bz0 = *(const f32x4*)(bp + bj * HALF), bz1 = *(const f32x4*)(bp + bj * HALF + 4);
                const float qsc = (pn == 0 || pn == 3 || (pn == 4 && bj == 0)) ? 0.125f * 1.4426950408889634f : 1.0f;
                const bool isk = (pn == 1) || (pn == 4 && bj == 1);
                float kmx = 0.f;
#pragma unroll
                for (int ai = 0; ai < 2; ++ai)
#pragma unroll
                    for (int m = 0; m < 4; ++m) {
                        const int row = row0 + ai * HALF + m * 16;
                        const float rv = rsqrtf(rowss[row] * (1.0f / 1024.0f) + 1e-6f);
                        const f32x4 v0 = (acc[ai][bj][m][0] * rv + bz0) * qsc, v1 = (acc[ai][bj][m][1] * rv + bz1) * qsc;
                        if (isk) { float s2 = (v0[0] * v0[0] + v0[1] * v0[1]) + (v0[2] * v0[2] + v0[3] * v0[3]) + (v1[0] * v1[0] + v1[1] * v1[1]) + (v1[2] * v1[2] + v1[3] * v1[3]);
                            s2 += __shfl_xor(s2, 16); s2 += __shfl_xor(s2, 32); kmx = fmaxf(kmx, s2); }
                        u32x4 w; w.x = pk_bf16(v0[0], v0[1]); w.y = pk_bf16(v0[2], v0[3]); w.z = pk_bf16(v1[0], v1[1]); w.w = pk_bf16(v1[2], v1[3]);
                        *(u32x4*)(base + (size_t)row * pitch) = w;
                    }
                if (isk) { kmx = fmaxf(kmx, __shfl_xor(kmx, 1)); kmx = fmaxf(kmx, __shfl_xor(kmx, 2)); kmx = fmaxf(kmx, __shfl_xor(kmx, 4)); kmx = fmaxf(kmx, __shfl_xor(kmx, 8));
                    if (fr == 0 && fqo == 0) { const int grp = pn == 1 ? 0 : 1; const int head = pn == 1 ? bj * 2 + (wc >> 1) : (wc >> 1);
                        atomicMax(kmax + (grp * 4 + head) * 2 + (wc & 1), __float_as_uint(kmx * 1.02f)); } }
            }
        } else {
            const bool isq = (pn == 6) || (wc < 2);
            const int hcol = (pn == 6) ? 64 * wc : (wc < 2 ? 64 * (4 + wc) : 64 * (wc - 2));
            bf16_t* base = qkv + (isq ? OFF_QC : OFF_KC) + hcol + 8 * fqo;
            const int pitch = isq ? 384 : 128;
            const float* gw = (isq ? gq : gk) + 4 * fqo;
            const float osc = isq ? 0.125f * 1.4426950408889634f : 1.0f;
#pragma unroll
            for (int ai = 0; ai < 2; ++ai)
#pragma unroll
                for (int m = 0; m < 4; ++m) {
                    const int row = row0 + ai * HALF + m * 16; const int t = row & 16383;
                    const float rv = rsqrtf(rowss[row] * (1.0f / 1024.0f) + 1e-6f);
                    float ss = 0.f; f32x4 hv[2][2];
#pragma unroll
                    for (int bj = 0; bj < 2; ++bj)
#pragma unroll
                        for (int n = 0; n < 2; ++n) { const f32x4 v = acc[ai][bj][m][n] * rv + *(const f32x4*)(bp + bj * HALF + 4 * n); hv[bj][n] = v; ss += (v[0] * v[0] + v[1] * v[1]) + (v[2] * v[2] + v[3] * v[3]); }
                    ss += __shfl_xor(ss, 16); ss += __shfl_xor(ss, 32);
                    const float rinv = rsqrtf(ss * (1.0f / 64.0f) + 1e-6f) * osc;
#pragma unroll
                    for (int bj = 0; bj < 2; ++bj) {
                        const int pos = bj == 0 ? (t >> 6) : (t & 63);
                        const f32x4 c = *(const f32x4*)(ropec + pos * 16 + 4 * fqo), s = *(const f32x4*)(ropes + pos * 16 + 4 * fqo);
                        const f32x4 x1 = hv[bj][0] * rinv * *(const f32x4*)(gw + 32 * bj), x2 = hv[bj][1] * rinv * *(const f32x4*)(gw + 32 * bj + 16);
                        const f32x4 o1 = x1 * c - x2 * s, o2 = x2 * c + x1 * s;
                        u32x4 w; w.x = pk_bf16(o1[0], o1[1]); w.y = pk_bf16(o1[2], o1[3]); w.z = pk_bf16(o2[0], o2[1]); w.w = pk_bf16(o2[2], o2[3]);
                        *(u32x4*)(base + (size_t)row * pitch + 32 * bj) = w;
                    }
                    asm volatile("" ::: "memory");
                }
        }
    }
};

template <bool GN> struct EpiResid {
    static constexpr bool PERM = true, AFTER_DRAIN = false, PROBE2 = false, KHOOK = GN;
    const bf16_t* base; bf16_t* out; const float* gate; int gstride;
    float* rowss;
    const float* gss;
    __device__ __forceinline__ void khook(f32x4 (&acc)[2][2][4][2], const Unit& u, int t, int wr, int fr) const {
        const int row0 = u.pm * BM + wr * 64 + fr;
        const float* s0 = gss + (t == 4 ? 0 : 32768); const float w0 = t == 4 ? (1.0f / 256.0f) : (1.0f / 384.0f);
#pragma unroll
        for (int ai = 0; ai < 2; ++ai)
#pragma unroll
            for (int m = 0; m < 4; ++m) { const int row = row0 + ai * HALF + m * 16;
                const float ratio = rsqrtf(s0[row] * w0 + 1e-6f) * __builtin_sqrtf(s0[32768 + row] * (1.0f / 384.0f) + 1e-6f);
#pragma unroll
                for (int bj = 0; bj < 2; ++bj)
#pragma unroll
                    for (int n = 0; n < 2; ++n) acc[ai][bj][m][n] *= ratio; }
    }
    __device__ __forceinline__ void operator()(const f32x4 (&acc)[2][2][4][2], const Unit& u, int wr, int wc, int fr, int fq) const {
        const int row0 = u.pm * BM + wr * 64 + fr; const int b = (u.pm * BM) >> 14;
        int fqo = fq; asm volatile("" : "+v"(fqo));
        const int col0 = u.pn * BM + wc * 32 + 8 * fqo;
        float ss[2][4];
#pragma unroll
        for (int ai = 0; ai < 2; ++ai)
#pragma unroll
            for (int m = 0; m < 4; ++m) ss[ai][m] = 0.f;
#pragma unroll
        for (int bj = 0; bj < 2; ++bj) {
            f32x4 gv[2];
#pragma unroll
            for (int n = 0; n < 2; ++n) gv[n] = *(const f32x4*)(gate + (size_t)b * gstride + col0 + bj * HALF + 4 * n);
            u32x4 pq[2][4];
#pragma unroll
            for (int ai = 0; ai < 2; ++ai)
#pragma unroll
                for (int m = 0; m < 4; ++m) pq[ai][m] = *(const u32x4*)(base + (size_t)(row0 + ai * HALF + m * 16) * 1024 + col0 + bj * HALF);
            asm volatile("" ::: "memory");
#pragma unroll
            for (int ai = 0; ai < 2; ++ai) {
#pragma unroll
                for (int m = 0; m < 4; ++m) { const size_t off = (size_t)(row0 + ai * HALF + m * 16) * 1024 + col0 + bj * HALF;
                    float rc = 1.0f; if constexpr (GN) rc = rsqrtf(gss[2 * 32768 + row0 + ai * HALF + m * 16] * (1.0f / 384.0f) + 1e-6f);
                    const u32x4 q = pq[ai][m];
                    const f32x2 qa_ = up_f16(q.x), qb_ = up_f16(q.y), qc_ = up_f16(q.z), qd_ = up_f16(q.w);
                    const f32x4 x0 = (f32x4){qa_[0], qa_[1], qb_[0], qb_[1]} + gv[0] * (acc[ai][bj][m][0] * rc),
                                x1 = (f32x4){qc_[0], qc_[1], qd_[0], qd_[1]} + gv[1] * (acc[ai][bj][m][1] * rc);
                    { u32x4 wx; wx.x = pk_f16(x0[0], x0[1]); wx.y = pk_f16(x0[2], x0[3]); wx.z = pk_f16(x1[0], x1[1]); wx.w = pk_f16(x1[2], x1[3]); *(u32x4*)(out + off) = wx; }
                    ss[ai][m] += ((x0[0] * x0[0] + x0[1] * x0[1]) + (x0[2] * x0[2] + x0[3] * x0[3])) + ((x1[0] * x1[0] + x1[1] * x1[1]) + (x1[2] * x1[2] + x1[3] * x1[3]));
                }
                asm volatile("" ::: "memory");
            }
        }
#pragma unroll
        for (int ai = 0; ai < 2; ++ai)
#pragma unroll
            for (int m = 0; m < 4; ++m) { float t = ss[ai][m]; t += __shfl_xor(t, 16); t += __shfl_xor(t, 32);
                if (fq == 0) atomicAdd(rowss + row0 + ai * HALF + m * 16, t); }
    }
};

struct EpiSwiGLU {
    static constexpr bool PERM = true, AFTER_DRAIN = false, PROBE2 = true, KHOOK = false;
    bf16_t* act; const float* rowss; const float* bias;
    __device__ __forceinline__ void operator()(const f32x4 (&acc)[2][2][4][2], const Unit& u, int wr, int wc, int fr, int fq) const {
        const int row0 = u.pm * BM + wr * 64 + fr; const int col0 = u.pn * HALF + wc * 32 + 8 * fq;
        const float* bp = bias + (size_t)((u.pm * BM) >> 14) * 5632 + u.pn * BM + wc * 32 + 8 * fq;
        f32x4 bz[2][2];
#pragma unroll
        for (int bj = 0; bj < 2; ++bj)
#pragma unroll
            for (int n = 0; n < 2; ++n) bz[bj][n] = *(const f32x4*)(bp + bj * HALF + 4 * n);
#pragma unroll
        for (int ai = 0; ai < 2; ++ai)
#pragma unroll
            for (int m = 0; m < 4; ++m) {
                float o[8]; const float rv = rsqrtf(rowss[row0 + ai * HALF + m * 16] * (1.0f / 1024.0f) + 1e-6f);
#pragma unroll
                for (int n = 0; n < 2; ++n)
#pragma unroll
                    for (int j = 0; j < 4; ++j) { const float g = acc[ai][0][m][n][j] * rv + bz[0][n][j], up = acc[ai][1][m][n][j] * rv + bz[1][n][j];
                        o[4 * n + j] = g * __builtin_amdgcn_rcpf(1.0f + __expf(-g)) * up; }
                u32x4 w; w.x = pk_bf16(o[0], o[1]); w.y = pk_bf16(o[2], o[3]); w.z = pk_bf16(o[4], o[5]); w.w = pk_bf16(o[6], o[7]);
                *(u32x4*)(act + (size_t)(row0 + ai * HALF + m * 16) * 2816 + col0) = w;
            }
    }
};

typedef _Float16 f16x8_t __attribute__((ext_vector_type(8)));
template <bool F16> __device__ __forceinline__ f32x4 mma16(bf16x8 b, bf16x8 a, f32x4 c) {
    if constexpr (F16) return __builtin_amdgcn_mfma_f32_16x16x32_f16(__builtin_bit_cast(f16x8_t, b), __builtin_bit_cast(f16x8_t, a), c, 0, 0, 0);
    else return __builtin_amdgcn_mfma_f32_16x16x32_bf16(b, a, c, 0, 0, 0);
}
template <class Epi, class Sched, bool ALIGN_EPI = false, bool SP2 = false, bool F16 = false>
__device__ __forceinline__ void gemm_phase(PG8_LAS unsigned char* lds, const Gemm g, const Sched& S, const Epi& E) {
    int tid_l = threadIdx.x; asm volatile("" : "+v"(tid_l));
    const int tid = tid_l, wid = __builtin_amdgcn_readfirstlane(tid >> 6), lane = tid & 63, wr = wid >> 2, wc = wid & 3, fr = lane & 15, fq = lane >> 4;
    const int K = g.K, nt = K / BK;
    unsigned voffA[2], voffB[2];
#pragma unroll
    for (int i = 0; i < 2; ++i) { int R, C; stage_rc(tid * 16 + i * 8192, R, C); const int Rb = Epi::PERM ? ((R & ~31) + perm32(R & 31)) : R;
        voffA[i] = (unsigned)(R * K + C) * 2u; voffB[i] = (unsigned)(Rb * K + C) * 2u; }
    const size_t kstep = (size_t)(BK * 2);
    const size_t hstep = (size_t)HALF * K * 2;
    const size_t tstep = 2 * hstep;
    const unsigned ldsw = (unsigned)wid * 1024u;
    const int aoff = lds_byte(wr * 64 + fr, fq * 8), boff = lds_byte(wc * 32 + fr, fq * 8);
#define PG8_SA(b, h) (((b) * 2 + (h)) * HTB)
#define PG8_SB(b, h) ((4 + (b) * 2 + (h)) * HTB)
#define PG8_STAGE(bufoff, gbase, voff) do { _Pragma("unroll") for (int _i = 0; _i < 2; ++_i) \
        __builtin_amdgcn_global_load_lds((const unsigned*)((const char*)(gbase) + (voff)[_i]), (PG8_LAS unsigned*)(lds + (bufoff) + ldsw + _i * 8192), 16, 0, 0); } while (0)
#define PG8_LDA(dst, b, h) do { _Pragma("unroll") for (int m = 0; m < 4; ++m) _Pragma("unroll") for (int k = 0; k < 2; ++k) dst[m][k] = *(const PG8_LAS bf16x8*)(lds + PG8_SA(b, h) + aoff + m * 2048 + k * 1024); } while (0)
#define PG8_LDB(dst, b, h) do { _Pragma("unroll") for (int n = 0; n < 2; ++n) _Pragma("unroll") for (int k = 0; k < 2; ++k) dst[n][k] = *(const PG8_LAS bf16x8*)(lds + PG8_SB(b, h) + boff + n * 2048 + k * 1024); } while (0)
#define PG8_MMA(ai, bj, At, Bt) do { __builtin_amdgcn_s_setprio(1); _Pragma("unroll") for (int m = 0; m < 4; ++m) _Pragma("unroll") for (int n = 0; n < 2; ++n) _Pragma("unroll") for (int k = 0; k < 2; ++k) \
        acc[ai][bj][m][n] = mma16<F16>(Bt[n][k], At[m][k], acc[ai][bj][m][n]); __builtin_amdgcn_s_setprio(0); } while (0)
#define PG8_WAIT_V(n) asm volatile("s_waitcnt vmcnt(" #n ")" ::: "memory")
#define PG8_WAIT_L(n) asm volatile("s_waitcnt lgkmcnt(" #n ")" ::: "memory")
#define PG8_BAR __builtin_amdgcn_s_barrier()
#define PG8_SCHED __builtin_amdgcn_sched_barrier(0)
    Unit cur, nxt; int ui = 0;
    if (!S.next(0, cur)) return;
    f32x4 acc[2][2][4][2];
#pragma unroll
    for (int a = 0; a < 2; ++a)
#pragma unroll
        for (int b = 0; b < 2; ++b)
#pragma unroll
            for (int m = 0; m < 4; ++m)
#pragma unroll
                for (int n = 0; n < 2; ++n) acc[a][b][m][n] = (f32x4){0.f, 0.f, 0.f, 0.f};
    bf16x8 At[4][2], B0[2][2], B1[2][2];
    const char* cA = (const char*)g.A + (size_t)cur.pm * tstep; const char* cB = (const char*)g.Bt + (size_t)cur.pn * tstep + (cur.pm >= g.mhalf ? g.bstride : (size_t)0);
    S.a_ready(cur);
    if constexpr (SP2) {
        PG8_STAGE(PG8_SB(0, 0), cB, voffB); PG8_STAGE(PG8_SB(0, 1), cB + hstep, voffB); PG8_STAGE(PG8_SA(0, 0), cA, voffA); PG8_STAGE(PG8_SA(0, 1), cA + hstep, voffA);
        if (wr == 1) PG8_BAR;
        PG8_WAIT_V(2); PG8_BAR;
        PG8_STAGE(PG8_SB(1, 0), cB + kstep, voffB); PG8_STAGE(PG8_SA(1, 0), cA + kstep, voffA); PG8_STAGE(PG8_SB(1, 1), cB + hstep + kstep, voffB);
        PG8_WAIT_V(6); PG8_BAR;
    } else {
        PG8_STAGE(PG8_SB(0, 0), cB, voffB); PG8_STAGE(PG8_SA(0, 0), cA, voffA); PG8_STAGE(PG8_SB(0, 1), cB + hstep, voffB); PG8_STAGE(PG8_SA(0, 1), cA + hstep, voffA);
        if (wr == 1) PG8_BAR;
        PG8_WAIT_V(4); PG8_BAR;
        PG8_STAGE(PG8_SB(1, 0), cB + kstep, voffB); PG8_STAGE(PG8_SA(1, 0), cA + kstep, voffA); PG8_STAGE(PG8_SB(1, 1), cB + hstep + kstep, voffB);
        PG8_WAIT_V(6); PG8_BAR;
    }
    for (;;) {
        const bool has_next = S.next(ui + 1, nxt);
        const char* nA = has_next ? (const char*)g.A + (size_t)nxt.pm * tstep : cA; const char* nB = has_next ? (const char*)g.Bt + (size_t)nxt.pn * tstep + (nxt.pm >= g.mhalf ? g.bstride : (size_t)0) : cB;
        for (int t = 0; t < nt; t += 2) {
            if constexpr (Epi::KHOOK) { if (t == 4 || t == 10) E.khook(acc, cur, t, wr, fr); }
            const bool last = (t == nt - 2);
            const char* a1 = cA + (size_t)(t + 1) * kstep;
            const char* a2 = last ? nA : cA + (size_t)(t + 2) * kstep; const char* b2 = last ? nB : cB + (size_t)(t + 2) * kstep;
            const char* a3 = a2 + kstep; const char* b3 = b2 + kstep;
            if (last && has_next) S.a_ready(nxt);
            if constexpr (SP2) {
            PG8_LDB(B0, 0, 0); PG8_LDB(B1, 0, 1); PG8_SCHED; PG8_LDA(At, 0, 0); PG8_STAGE(PG8_SA(1, 1), a1 + hstep, voffA);
            PG8_WAIT_V(8); PG8_WAIT_L(0); PG8_BAR; PG8_MMA(0, 0, At, B0); PG8_MMA(0, 1, At, B1); PG8_BAR; PG8_SCHED;
            PG8_LDA(At, 0, 1); PG8_STAGE(PG8_SB(0, 0), b2, voffB); PG8_STAGE(PG8_SB(0, 1), b2 + hstep, voffB); PG8_STAGE(PG8_SA(0, 0), a2, voffA);
            PG8_WAIT_V(8); PG8_WAIT_L(0); PG8_BAR; PG8_MMA(1, 0, At, B0); PG8_MMA(1, 1, At, B1); PG8_BAR; PG8_SCHED;
            PG8_LDB(B0, 1, 0); PG8_LDB(B1, 1, 1); PG8_SCHED; PG8_LDA(At, 1, 0); PG8_STAGE(PG8_SA(0, 1), a2 + hstep, voffA);
            PG8_WAIT_V(8); PG8_WAIT_L(0); PG8_BAR; PG8_MMA(0, 0, At, B0); PG8_MMA(0, 1, At, B1); PG8_BAR; PG8_SCHED;
            PG8_LDA(At, 1, 1); PG8_STAGE(PG8_SB(1, 0), b3, voffB); PG8_STAGE(PG8_SB(1, 1), b3 + hstep, voffB); PG8_STAGE(PG8_SA(1, 0), a3, voffA);
            PG8_WAIT_V(8); PG8_WAIT_L(0); PG8_BAR; PG8_MMA(1, 0, At, B0); PG8_MMA(1, 1, At, B1); PG8_BAR; PG8_SCHED;
            } else {
            PG8_LDB(B0, 0, 0); PG8_SCHED; PG8_LDA(At, 0, 0); PG8_STAGE(PG8_SA(1, 1), a1 + hstep, voffA);
            PG8_WAIT_L(8); PG8_BAR; PG8_WAIT_L(0); PG8_MMA(0, 0, At, B0); PG8_BAR; PG8_SCHED;
            PG8_LDB(B1, 0, 1); PG8_STAGE(PG8_SB(0, 0), b2, voffB);
            PG8_BAR; PG8_WAIT_L(0); PG8_MMA(0, 1, At, B1); PG8_BAR;
            PG8_LDA(At, 0, 1); PG8_STAGE(PG8_SA(0, 0), a2, voffA);
            PG8_BAR; PG8_WAIT_L(0); PG8_MMA(1, 0, At, B0); PG8_BAR; PG8_SCHED;
            PG8_STAGE(PG8_SB(0, 1), b2 + hstep, voffB);
            PG8_WAIT_V(6); PG8_BAR; PG8_MMA(1, 1, At, B1); PG8_BAR;
            PG8_LDB(B0, 1, 0); PG8_SCHED; PG8_LDA(At, 1, 0); PG8_STAGE(PG8_SA(0, 1), a2 + hstep, voffA);
            PG8_WAIT_L(8); PG8_BAR; PG8_WAIT_L(0); PG8_MMA(0, 0, At, B0); PG8_BAR; PG8_SCHED;
            PG8_LDB(B1, 1, 1); PG8_STAGE(PG8_SB(1, 0), b3, voffB);
            PG8_BAR; PG8_WAIT_L(0); PG8_MMA(0, 1, At, B1); PG8_BAR;
            PG8_LDA(At, 1, 1); PG8_STAGE(PG8_SA(1, 0), a3, voffA);
            PG8_BAR; PG8_WAIT_L(0); PG8_MMA(1, 0, At, B0); PG8_BAR; PG8_SCHED;
            PG8_STAGE(PG8_SB(1, 1), b3 + hstep, voffB);
            PG8_WAIT_V(6); PG8_BAR; PG8_MMA(1, 1, At, B1); PG8_BAR;
            }
        }
        if constexpr (ALIGN_EPI) { if (wr == 0) PG8_BAR; }
        if constexpr (!Epi::AFTER_DRAIN) { E(acc, cur, wr, wc, fr, fq);
#if PROBE_EPI
            if constexpr (Epi::PROBE2) { asm volatile("" ::: "memory"); E(acc, cur, wr, wc, fr, fq); }
#endif
            S.done(cur); }
        if (!has_next) break;
#pragma unroll
        for (int a = 0; a < 2; ++a)
#pragma unroll
            for (int b = 0; b < 2; ++b)
#pragma unroll
                for (int m = 0; m < 4; ++m)
#pragma unroll
                    for (int n = 0; n < 2; ++n) acc[a][b][m][n] = (f32x4){0.f, 0.f, 0.f, 0.f};
        cur = nxt; cA = nA; cB = nB; ++ui;
        if constexpr (ALIGN_EPI) { if (wr == 1) PG8_BAR; }
    }
    PG8_WAIT_V(0);
    if constexpr (!ALIGN_EPI) { if (wr == 0) PG8_BAR; }
    PG8_BAR;
    if constexpr (Epi::AFTER_DRAIN) { E.fused(acc, cur, wr, wc, fr, fq, lds, wid, lane); S.done(cur); }
#undef PG8_SA
#undef PG8_SB
#undef PG8_STAGE
#undef PG8_LDA
#undef PG8_LDB
#undef PG8_MMA
#undef PG8_WAIT_V
#undef PG8_WAIT_L
#undef PG8_BAR
#undef PG8_SCHED
}
}
namespace attn_body {
using bf16=__hip_bfloat16;
using bf16x8=__attribute__((ext_vector_type(8)))short;
using s16x4=__attribute__((ext_vector_type(4)))short;
using f32x16=__attribute__((ext_vector_type(16)))float;
using u32x4=__attribute__((ext_vector_type(4)))unsigned;
constexpr int SEQ=16384,D=64,QP=384,KP=128,OP=1024;
constexpr int NW=8,QBLK=32,QB=QBLK*NW,KVBLK=64,NQB=SEQ/QB;
constexpr int ATTN_UNIT_ROWS=QB;
__device__ __forceinline__ int crow(int r,int hi){return (r&3)+8*(r>>2)+4*hi;}
#define SBAR() __builtin_amdgcn_sched_barrier(0)
__device__ __forceinline__ void cmask(f32x16&p0,f32x16&p1,int jb,int qrel,int hi){
  const float NEG=-INFINITY; int kb=64*jb+4*hi;
  #pragma unroll
  for(int r=0;r<16;++r){int kv=kb+(r&3)+8*(r>>2); if(kv>qrel)p0[r]=NEG; if(kv+32>qrel)p1[r]=NEG;}
}

constexpr int NSLOT=3, SLOTB=8192;
constexpr int LDS_K=0, LDS_V=NSLOT*SLOTB, LDS_WS=2*NSLOT*SLOTB, LDS_OST=LDS_WS+NW*64*4, LDS_BYTES=LDS_OST+NW*4096;
constexpr float C2=0.125f*1.4426950408889634f;
__device__ __forceinline__ void glds16(const void*gsrc,unsigned lds_dst){unsigned keep;
  asm volatile("s_mov_b32 %0, m0\n\ts_mov_b32 m0, %2\n\ts_nop 0\n\tglobal_load_lds_dwordx4 %1, off\n\ts_mov_b32 m0, %0":"=&s"(keep):"v"(gsrc),"s"(lds_dst):"memory");}
__device__ __forceinline__ float max3f(float a,float b,float c){float r;asm("v_max3_f32 %0, %1, %2, %3":"=v"(r):"v"(a),"v"(b),"v"(c));return r;}
__device__ __forceinline__ float max2f(float a,float b){float r;asm("v_max_f32_e32 %0, %1, %2":"=v"(r):"v"(a),"v"(b));return r;}
__device__ __forceinline__ float fadd_s(float a,float b){float r;asm("v_add_f32_e32 %0, %1, %2":"=v"(r):"v"(a),"v"(b));return r;}
__device__ __forceinline__ float fsub_s(float a,float b){float r;asm("v_sub_f32_e32 %0, %1, %2":"=v"(r):"v"(a),"v"(b));return r;}
typedef float f32x2_t __attribute__((ext_vector_type(2))); typedef __bf16 bf16x2_t __attribute__((ext_vector_type(2)));
__device__ __forceinline__ unsigned cvtpk_s(float lo,float hi){f32x2_t v={lo,hi};bf16x2_t b=__builtin_convertvector(v,bf16x2_t);return __builtin_bit_cast(unsigned,b);}
#define WAIT_BAR(N) asm volatile("s_waitcnt vmcnt(" #N ") lgkmcnt(0)\n\ts_barrier":::"memory")

__device__ __forceinline__ void qkt(f32x16&p0,f32x16&p1,const char*Kslot,const bf16x8*qr,const f32x16&negm,int r32,int hi){
  const char*kb=Kslot+hi*1024+r32*16;
  #pragma unroll
  for(int d0=0;d0<4;++d0){
    const bf16x8 b0=*reinterpret_cast<const bf16x8*>(kb+d0*2048);
    const bf16x8 b1=*reinterpret_cast<const bf16x8*>(kb+d0*2048+512);
    if(d0==0){p0=__builtin_amdgcn_mfma_f32_32x32x16_bf16(b0,qr[0],negm,0,0,0);p1=__builtin_amdgcn_mfma_f32_32x32x16_bf16(b1,qr[0],negm,0,0,0);}
    else{p0=__builtin_amdgcn_mfma_f32_32x32x16_bf16(b0,qr[d0],p0,0,0,0);p1=__builtin_amdgcn_mfma_f32_32x32x16_bf16(b1,qr[d0],p1,0,0,0);}}
}
typedef __attribute__((address_space(3))) const char* lds_cptr;
typedef short v4i16_t __attribute__((ext_vector_type(4)));
__device__ __forceinline__ void kload8(bf16x8*kf,lds_cptr kp){
  kf[0]=*(const __attribute__((address_space(3))) bf16x8*)(kp);      kf[1]=*(const __attribute__((address_space(3))) bf16x8*)(kp+512);
  kf[2]=*(const __attribute__((address_space(3))) bf16x8*)(kp+2048); kf[3]=*(const __attribute__((address_space(3))) bf16x8*)(kp+2560);
  kf[4]=*(const __attribute__((address_space(3))) bf16x8*)(kp+4096); kf[5]=*(const __attribute__((address_space(3))) bf16x8*)(kp+4608);
  kf[6]=*(const __attribute__((address_space(3))) bf16x8*)(kp+6144); kf[7]=*(const __attribute__((address_space(3))) bf16x8*)(kp+6656);
}
__device__ __forceinline__ void kload2(bf16x8*kf,lds_cptr kp,int j){ kf[2*j]=*(const __attribute__((address_space(3))) bf16x8*)(kp+j*2048); kf[2*j+1]=*(const __attribute__((address_space(3))) bf16x8*)(kp+j*2048+512); }
__device__ __forceinline__ s16x4 vtr(lds_cptr p){ return __builtin_bit_cast(s16x4,__builtin_amdgcn_ds_read_tr16_b64_v4i16((__attribute__((address_space(3))) v4i16_t*)p)); }
__device__ __forceinline__ float rowmax(const f32x16&p0,const f32x16&p1){
  float a=max3f(p0[0],p0[1],p1[0]),b=max3f(p0[2],p0[3],p1[1]);a=max3f(a,p1[2],p1[3]);
  #pragma unroll
  for(int r=4;r<16;r+=4){a=max3f(a,p0[r],p0[r+1]);b=max3f(b,p0[r+2],p0[r+3]);a=max3f(a,p1[r],p1[r+1]);b=max3f(b,p1[r+2],p1[r+3]);}
  const float m=max2f(a,b);
  auto rr=__builtin_amdgcn_permlane32_swap(__float_as_uint(m),__float_as_uint(m),false,false);
  return max2f(__uint_as_float(rr[0]),__uint_as_float(rr[1]));
}
__device__ __forceinline__ void pv(f32x16*o,int vb,bf16x8 pa0,bf16x8 pa1,bf16x8 pa2,bf16x8 pa3){
  #pragma unroll
  for(int d0=0;d0<2;++d0){s16x4 lo[4],hi[4];
    #pragma unroll
    for(int ks=0;ks<4;++ks){
      asm volatile("ds_read_b64_tr_b16 %0,%1 offset:%c2":"=&v"(lo[ks]):"v"(vb),"i"(d0*4096+ks*1024):"memory");
      asm volatile("ds_read_b64_tr_b16 %0,%1 offset:%c2":"=&v"(hi[ks]):"v"(vb),"i"(d0*4096+ks*1024+512):"memory");}
    asm volatile("s_waitcnt lgkmcnt(0)":::"memory");SBAR();
    #define PK(k) (bf16x8){lo[k][0],lo[k][1],lo[k][2],lo[k][3],hi[k][0],hi[k][1],hi[k][2],hi[k][3]}
    o[d0]=__builtin_amdgcn_mfma_f32_32x32x16_bf16(pa0,PK(0),o[d0],0,0,0);
    o[d0]=__builtin_amdgcn_mfma_f32_32x32x16_bf16(pa1,PK(1),o[d0],0,0,0);
    o[d0]=__builtin_amdgcn_mfma_f32_32x32x16_bf16(pa2,PK(2),o[d0],0,0,0);
    o[d0]=__builtin_amdgcn_mfma_f32_32x32x16_bf16(pa3,PK(3),o[d0],0,0,0);
    #undef PK
  }
}

#ifndef ATTN_STORE16
#define ATTN_STORE16(p,v) (*(u32x4*)(p)=(v))
#endif
template<int THRL> __device__ __forceinline__ void attn_unit(int b,int h,int qb,const bf16*Q,const bf16*__restrict__ K,const bf16*__restrict__ V,bf16*O,float*gssrow,float mref,char*shm){
  int tid_l=threadIdx.x; asm volatile("":"+v"(tid_l)); const int tid=tid_l,lane=tid&63,r32=lane&31,hi=lane>>5; const int wid=__builtin_amdgcn_readfirstlane(tid>>6);
  const long rowbase=(long)b*SEQ; const int q0=qb*QB;
  const bf16*Qw=Q+(rowbase+q0+wid*QBLK)*QP+h*D;
  const int g=h/3; const bf16*Kh=K+rowbase*KP+g*D,*Vh=V+rowbase*KP+g*D;
  const unsigned lds0=(unsigned)(uintptr_t)shm;
  float*wsf=(float*)(shm+LDS_WS)+wid*64;
  const bf16*ksrc=Kh+(long)lane*KP+wid*8;
  const bf16*vsrc=Vh+(long)(16*(wid&3)+(lane>>2))*KP+(wid>>2)*32+(lane&3)*8;
  const unsigned kdst=lds0+LDS_K+wid*1024, vdst=lds0+LDS_V+wid*1024;
  #define DMA_K(t,slot) glds16(ksrc+(long)(t)*KVBLK*KP,(unsigned)__builtin_amdgcn_readfirstlane(kdst+(slot)))
  #define DMA_V(t,slot) glds16(vsrc+(long)(t)*KVBLK*KP,(unsigned)__builtin_amdgcn_readfirstlane(vdst+(slot)))
  const int vb0=(int)(lds0+LDS_V)+((lane>>4)&1)*32+(lane&3)*8+(4*hi+((lane&15)>>2))*64;
  const char*Kbase=shm+LDS_K; bf16x8 kf[8];
  const lds_cptr shm3=(lds_cptr)shm; const lds_cptr kp0=shm3+LDS_K+hi*1024+r32*16; const lds_cptr vp0=shm3+LDS_V+((lane>>4)&1)*32+(lane&3)*8+(4*hi+((lane&15)>>2))*64;
  const int NT=SEQ/KVBLK;
  DMA_K(0,0);DMA_V(0,0);DMA_K(1,SLOTB);
  bf16x8 qr[4];
  #pragma unroll
  for(int d0=0;d0<4;++d0)qr[d0]=*reinterpret_cast<const bf16x8*>(&Qw[(long)r32*QP+d0*16+hi*8]);
  float l_reg=0.f;f32x16 o[2];o[0]=f32x16{};o[1]=f32x16{};f32x16 negm;_Pragma("unroll") for(int r=0;r<16;++r)negm[r]=-mref;asm volatile("":"+v"(negm));

  #define CMASK(P0,P1,t) do{}while(0)
  #define START(P0,P1) do{ _Pragma("unroll") for(int r=0;r<16;++r)P0[r]=__builtin_amdgcn_exp2f(P0[r]); }while(0)
  #define RESC() do{}while(0)
  f32x16 pA0,pA1,pB0,pB1;
  int sl_prev=0,sl_cur=0,sl_next=SLOTB;
  #define ROT() do{sl_prev=sl_cur;sl_cur=sl_next;sl_next=(sl_next==(NSLOT-1)*SLOTB)?0:sl_next+SLOTB;}while(0)
  DMA_K(2,2*SLOTB);
  WAIT_BAR(3);
  qkt(pA0,pA1,Kbase,qr,negm,r32,hi);asm volatile("s_nop 15\n\ts_nop 7":"+v"(pA0),"+v"(pA1));CMASK(pA0,pA1,0);
  START(pA0,pA1);
  _Pragma("unroll") for(int r=0;r<16;++r)pA1[r]=__builtin_amdgcn_exp2f(pA1[r]);
  WAIT_BAR(0);
  DMA_K(3,0);DMA_V(1,SLOTB);
  ROT();
  kload8(kf,kp0+sl_cur);
  WAIT_BAR(2);
  s16x4 vlo[8],vhi[8]; u32x4 pw0,pw1,pw2,pw3;
  #define PKW(P,B) cvtpk_s(P[B],P[B+1])
  #define PAF(k) __builtin_bit_cast(bf16x8,pw##k)
  #define VFR(i) (bf16x8){vlo[i][0],vlo[i][1],vlo[i][2],vlo[i][3],vhi[i][0],vhi[i][1],vhi[i][2],vhi[i][3]}
  #define PIN(x) asm volatile("":"+v"(x))
  #define MX3(a,b,c) __builtin_fmaxf(__builtin_fmaxf((a),(b)),(c))
  #define GAPA(MF,A0,A1,A2,A3,W0,W1,PW) do{ MF; sacc+=A0; sacc+=A1; sacc+=A2; sacc+=A3; PIN(sacc); W0; W1; PIN(PW); SBAR(); }while(0)
  #define EX(v) __builtin_amdgcn_exp2f(v)
  #define GAPB(MF,X,B) do{ MF; X[B]=EX(X[B]); X[B+1]=EX(X[B+1]); X[B+2]=EX(X[B+2]); X[B+3]=EX(X[B+3]); PIN(X); SBAR(); }while(0)
  #define VRD(i) do{ vlo[i]=vtr(vp_+(((i)>>2)*4096+((i)&3)*1024)); vhi[i]=vtr(vp_+(((i)>>2)*4096+((i)&3)*1024+512)); }while(0)
  #define KRD(G,j) do{ if(G){ kload2(kf,kp0+sl_next,j); SBAR(); } }while(0)
  #define STEP(C0,C1,P0,P1,t,GK,GV,GL) do{ SBAR(); \
    const lds_cptr vp_=vp0+sl_prev; \
    VRD(0); SBAR(); float sacc=(P0[0]+P0[1]); \
    GAPA(C0=__builtin_amdgcn_mfma_f32_32x32x16_bf16(kf[0],qr[0],negm,0,0,0), P0[2],P0[3],P0[4],P0[5],     pw0[0]=PKW(P0,0), pw0[1]=PKW(P0,2), pw0); \
    VRD(4); SBAR(); GAPA(C1=__builtin_amdgcn_mfma_f32_32x32x16_bf16(kf[1],qr[0],negm,0,0,0), P0[6],P0[7],P0[8],P0[9],     pw0[2]=PKW(P0,4), pw0[3]=PKW(P0,6), pw0); \
    VRD(1); SBAR(); GAPA(C0=__builtin_amdgcn_mfma_f32_32x32x16_bf16(kf[2],qr[1],C0,0,0,0),   P0[10],P0[11],P0[12],P0[13], pw1[0]=PKW(P0,8), pw1[1]=PKW(P0,10), pw1); \
    VRD(5); SBAR(); GAPA(C1=__builtin_amdgcn_mfma_f32_32x32x16_bf16(kf[3],qr[1],C1,0,0,0),   P0[14],P0[15],P1[0],P1[1],   pw1[2]=PKW(P0,12),pw1[3]=PKW(P0,14), pw1); \
    VRD(2); SBAR(); GAPA(C0=__builtin_amdgcn_mfma_f32_32x32x16_bf16(kf[4],qr[2],C0,0,0,0),   P1[2],P1[3],P1[4],P1[5],     pw2[0]=PKW(P1,0), pw2[1]=PKW(P1,2), pw2); \
    VRD(6); SBAR(); GAPA(C1=__builtin_amdgcn_mfma_f32_32x32x16_bf16(kf[5],qr[2],C1,0,0,0),   P1[6],P1[7],P1[8],P1[9],     pw2[2]=PKW(P1,4), pw2[3]=PKW(P1,6), pw2); \
    VRD(3); SBAR(); GAPA(C0=__builtin_amdgcn_mfma_f32_32x32x16_bf16(kf[6],qr[3],C0,0,0,0),   P1[10],P1[11],P1[12],P1[13], pw3[0]=PKW(P1,8), pw3[1]=PKW(P1,10), pw3); \
    VRD(7); SBAR(); GAPA(C1=__builtin_amdgcn_mfma_f32_32x32x16_bf16(kf[7],qr[3],C1,0,0,0),   P1[14],P1[15],0.f,0.f,       pw3[2]=PKW(P1,12),pw3[3]=PKW(P1,14), pw3); \
    l_reg+=sacc; \
    if(GK){DMA_K((t)+3,sl_cur);} if(GV){DMA_V((t)+1,sl_next);} \
    CMASK(C0,C1,t); \
    SBAR(); \
    GAPB(o[0]=__builtin_amdgcn_mfma_f32_32x32x16_bf16(PAF(0),VFR(0),o[0],0,0,0), C0,0); \
    GAPB(o[1]=__builtin_amdgcn_mfma_f32_32x32x16_bf16(PAF(0),VFR(4),o[1],0,0,0), C0,4); \
    KRD(GL,0); GAPB(o[0]=__builtin_amdgcn_mfma_f32_32x32x16_bf16(PAF(1),VFR(1),o[0],0,0,0), C0,8); \
    KRD(GL,1); GAPB(o[1]=__builtin_amdgcn_mfma_f32_32x32x16_bf16(PAF(1),VFR(5),o[1],0,0,0), C0,12); \
    KRD(GL,2); GAPB(o[0]=__builtin_amdgcn_mfma_f32_32x32x16_bf16(PAF(2),VFR(2),o[0],0,0,0), C1,0); \
    KRD(GL,3); GAPB(o[1]=__builtin_amdgcn_mfma_f32_32x32x16_bf16(PAF(2),VFR(6),o[1],0,0,0), C1,4); \
    GAPB(o[0]=__builtin_amdgcn_mfma_f32_32x32x16_bf16(PAF(3),VFR(3),o[0],0,0,0), C1,8); \
    GAPB(o[1]=__builtin_amdgcn_mfma_f32_32x32x16_bf16(PAF(3),VFR(7),o[1],0,0,0), C1,12); \
    }while(0)
  if(wid>=4)__builtin_amdgcn_s_setprio(1);
  int t=1;
  #undef CMASK
  #define CMASK(P0,P1,t) do{}while(0)
  for(;t+5<NT;t+=2){
    STEP(pB0,pB1,pA0,pA1,t,true,true,true);     WAIT_BAR(2); RESC(); ROT();
    STEP(pA0,pA1,pB0,pB1,t+1,true,true,true);   WAIT_BAR(2); RESC(); ROT();
  }
  #undef CMASK
  #define CMASK(P0,P1,t) do{}while(0)
  #define ENDW(tt) do{ if((tt)+3<NT){WAIT_BAR(2);} else if((tt)+2<NT){WAIT_BAR(1);} else {WAIT_BAR(0);} }while(0)
  for(;t+1<NT;t+=2){
    STEP(pB0,pB1,pA0,pA1,t,(t+3<NT),(t+1<NT),(t+1<NT));       ENDW(t);   RESC(); ROT();
    STEP(pA0,pA1,pB0,pB1,t+1,(t+4<NT),(t+2<NT),(t+2<NT));     ENDW(t+1); RESC(); ROT();
  }
  STEP(pB0,pB1,pA0,pA1,NT-1,false,false,false); RESC();
  { float sacc=pB0[0]+pB0[1]; _Pragma("unroll") for(int r=2;r<16;++r)sacc+=pB0[r]; _Pragma("unroll") for(int r=0;r<16;++r)sacc+=pB1[r]; l_reg+=sacc;
    pw0=(u32x4){PKW(pB0,0),PKW(pB0,2),PKW(pB0,4),PKW(pB0,6)};pw1=(u32x4){PKW(pB0,8),PKW(pB0,10),PKW(pB0,12),PKW(pB0,14)};pw2=(u32x4){PKW(pB1,0),PKW(pB1,2),PKW(pB1,4),PKW(pB1,6)};pw3=(u32x4){PKW(pB1,8),PKW(pB1,10),PKW(pB1,12),PKW(pB1,14)};
    SBAR(); pv(o,vb0+sl_cur,PAF(0),PAF(1),PAF(2),PAF(3)); }
  #undef PKW
  #undef PAF
  #undef VFR
  #undef PIN
  #undef MX3
  #undef GAPA
  #undef GAPB
  #undef EX
  #undef VRD
  #undef KRD
  #undef STEP
  #undef ENDW
  __builtin_amdgcn_s_setprio(0);
  {auto rr=__builtin_amdgcn_permlane32_swap(__float_as_uint(l_reg),__float_as_uint(l_reg),false,false);l_reg=__uint_as_float(rr[0])+__uint_as_float(rr[1]);}
  if(hi==0)wsf[32+r32]=l_reg;asm volatile("s_waitcnt lgkmcnt(0)":::"memory");
  float rli[16];
  #pragma unroll
  for(int r=0;r<16;++r)rli[r]=__builtin_amdgcn_rcpf(wsf[32+crow(r,hi)]);
  bf16*Ow=O+(rowbase+q0+wid*QBLK)*OP+h*D;
  { bf16*stg=(bf16*)(shm+LDS_OST)+wid*2048;
    #pragma unroll
    for(int r=0;r<16;++r){const int orow=crow(r,hi);
      #pragma unroll
      for(int d0=0;d0<2;++d0)stg[orow*64+d0*32+r32]=__float2bfloat16(o[d0][r]*rli[r]);}
    asm volatile("s_waitcnt lgkmcnt(0)":::"memory");
    #pragma unroll
    for(int i=0;i<4;++i){const int row=i*8+(lane>>3),ch=lane&7; const u32x4 v=*(const u32x4*)(stg+row*64+ch*8); ATTN_STORE16(Ow+(long)row*OP+ch*8,v);
      float ss=0.f;
      #pragma unroll
      for(int e=0;e<4;++e){const float lo=__uint_as_float(v[e]<<16),hi_=__uint_as_float(v[e]&0xffff0000u); ss+=lo*lo+hi_*hi_;}
      ss+=__shfl_xor(ss,1); ss+=__shfl_xor(ss,2); ss+=__shfl_xor(ss,4);
      if(ch==0)atomicAdd(gssrow+rowbase+q0+wid*QBLK+row,ss);} }
  asm volatile("s_waitcnt lgkmcnt(0)\n\ts_barrier":::"memory");
  #undef DMA_K
  #undef DMA_V
  #undef CMASK
  #undef START
  #undef RESC
  #undef ROT
}
#undef SBAR
#undef WAIT_BAR
}
#define LAS __attribute__((address_space(3)))
typedef unsigned short bf16;
typedef unsigned v4u __attribute__((ext_vector_type(4)));
typedef unsigned v2u __attribute__((ext_vector_type(2)));
typedef float f32x4 __attribute__((ext_vector_type(4)));
typedef float f32x16 __attribute__((ext_vector_type(16)));
typedef short bf16x8 __attribute__((ext_vector_type(8)));
typedef short s16x4 __attribute__((ext_vector_type(4)));
using pg8::pk_bf16;

#define XB_TMO      128
#define XB_XCNT(j)  (256  + 64 * (j))
#define XB_XSUB(j)  (1280 + 64 * (j))
#define XB_XGEN(j)  (2304 + 64 * (j))
#define XB_TOP      3328
#define XB_TOPGEN   3392
#define XCD_BAR_WORDS 3456
#define XB_SPIN_CAP (1u << 18)

__device__ __forceinline__ unsigned xb_ld(unsigned* p)              { return __hip_atomic_load(p, __ATOMIC_RELAXED, __HIP_MEMORY_SCOPE_AGENT); }
__device__ __forceinline__ unsigned xb_add(unsigned* p, unsigned v) { return __hip_atomic_fetch_add(p, v, __ATOMIC_RELAXED, __HIP_MEMORY_SCOPE_AGENT); }
__device__ __forceinline__ unsigned xb_xcc_id() { return (unsigned)__builtin_amdgcn_s_getreg((3 << 11) | 20) & 0xFu; }
#define XB_SPIN(cond, bar) do { unsigned _sp = 0; while (cond) { __builtin_amdgcn_s_sleep(1); \
    if ((++_sp & 255u) == 0u) { if (xb_ld(&(bar)[XB_TMO])) break; if (_sp > XB_SPIN_CAP) { atomicAdd(&(bar)[XB_TMO], 1u); break; } } } } while (0)

struct XcdBarrier {
    unsigned* bar; unsigned x;
    volatile LAS unsigned* st;
};

__device__ __forceinline__ XcdBarrier xcd_barrier_post(unsigned* bar, volatile LAS unsigned* st) {
    XcdBarrier b; b.bar = bar; b.x = xb_xcc_id(); b.st = st;
    if (threadIdx.x == 0) (void)xb_add(&bar[XB_XCNT(b.x)], 1u);
    return b;
}
__device__ __forceinline__ void xcd_barrier_complete(unsigned* bar, unsigned x, unsigned& nloc, unsigned& nx) {
    const unsigned G = gridDim.x * gridDim.y * gridDim.z;
    unsigned sum, cnt, mine, sp = 0u;
    for (;;) {
        sum = 0u; cnt = 0u; mine = 0u;
#pragma unroll
        for (unsigned j = 0; j < 16; ++j) { const unsigned c = xb_ld(&bar[XB_XCNT(j)]); sum += c; cnt += (c > 0u) ? 1u : 0u; mine = (j == x) ? c : mine; }
        if (sum == G) break;
        __builtin_amdgcn_s_sleep(1);
        if ((++sp & 255u) == 0u) { if (xb_ld(&bar[XB_TMO])) break; if (sp > XB_SPIN_CAP) { atomicAdd(&bar[XB_TMO], 1u); break; } }
    }
    nloc = mine > 0u ? mine : 1u; nx = cnt > 0u ? cnt : 1u;
}

__device__ __forceinline__ void xcd_barrier(const XcdBarrier& b) {
    asm volatile("s_waitcnt vmcnt(0)" ::: "memory");
    __syncthreads();
    if (threadIdx.x == 0) {
        unsigned* bar = b.bar;
        __builtin_amdgcn_s_waitcnt(0);
        unsigned nloc = b.st[0], nx = b.st[1];
        if (nloc == 0u) { xcd_barrier_complete(bar, b.x, nloc, nx); b.st[0] = nloc; b.st[1] = nx; }
        const unsigned old = xb_add(&bar[XB_XSUB(b.x)], 1u);
        const unsigned gen = old / nloc;
        if (old + 1u == (gen + 1u) * nloc) {
            __builtin_amdgcn_fence(__ATOMIC_RELEASE, "agent");
            asm volatile("s_waitcnt vmcnt(0)" ::: "memory");
            const unsigned og = xb_add(&bar[XB_TOP], 1u);
            const unsigned tg = og / nx;
            if (og + 1u == (tg + 1u) * nx) xb_add(&bar[XB_TOPGEN], 1u);
            else XB_SPIN(xb_ld(&bar[XB_TOPGEN]) == tg, bar);
            __builtin_amdgcn_fence(__ATOMIC_ACQUIRE, "agent");
            xb_add(&bar[XB_XGEN(b.x)], 1u);
            asm volatile("s_waitcnt vmcnt(0)" ::: "memory");
        } else {
            XB_SPIN(xb_ld(&bar[XB_XGEN(b.x)]) == gen, bar);
            __builtin_amdgcn_fence(__ATOMIC_ACQUIRE, "agent");
            asm volatile("s_waitcnt vmcnt(0)" ::: "memory");
        }
    }
    __syncthreads();
}


constexpr size_t MiB = 1u << 20;
constexpr size_t WS_BAR = 0;
constexpr size_t WS_MOD = 64 * 1024;
constexpr size_t WS_BIASIN = 160 * 1024;
constexpr size_t WS_BIASGU = 192 * 1024;
constexpr size_t WS_ROPEC = 288 * 1024;
constexpr size_t WS_ROPES = 304 * 1024;
constexpr size_t WS_MREF = 328 * 1024;
constexpr size_t WS_KMAX = 332 * 1024;
constexpr size_t WS_ROWSS = 384 * 1024;
constexpr size_t WS_SWB = 320 * 1024;
constexpr size_t WS_WIN = 368 * MiB;
constexpr size_t WS_WO = 9 * MiB;
constexpr size_t WS_WGU = 384 * MiB;
constexpr size_t WS_WDN = 35 * MiB;
constexpr size_t WS_GSS = 46 * MiB;
constexpr size_t WS_H = 48 * MiB;
constexpr size_t WS_QKV = 112 * MiB;
constexpr size_t WS_Y = 240 * MiB;
constexpr size_t WS_ACT = 112 * MiB;
constexpr size_t WS_XA = 304 * MiB;
constexpr size_t WS_END = 428 * MiB;

constexpr int LDS_BYTES = 135168;

__device__ __forceinline__ float wave_sum(float v) {
#pragma unroll
    for (int o = 1; o < 64; o <<= 1) v += __shfl_xor(v, o);
    return v;
}

__device__ __forceinline__ int permf(int i) { return 16 * ((i >> 2) & 1) + 4 * (i >> 3) + (i & 3); }
__device__ __forceinline__ void tr_item(const float* W, int K, int N, int k0, int sc0, bool perm, bf16* WT, int dr0, LAS float* scr, int lane, const float* ksc = nullptr) {
#pragma unroll 8
    for (int i = 0; i < 32; ++i) { const int kk = 2 * i + (lane >> 5); scr[kk * 33 + (lane & 31)] = W[(size_t)(k0 + kk) * N + sc0 + (lane & 31)]; }
    asm volatile("s_waitcnt lgkmcnt(0)" ::: "memory");
    const int c = lane & 7;
    float kq[8];
#pragma unroll
    for (int e = 0; e < 8; ++e) kq[e] = ksc ? ksc[k0 + 8 * c + e] : 1.0f;
#pragma unroll
    for (int j = 0; j < 4; ++j) { const int n = (lane >> 3) + 8 * j; const int ci = perm ? permf(n) : n; const LAS float* s = scr + (8 * c) * 33 + ci;
        v4u o; o.x = pk_bf16(s[0 * 33] * kq[0], s[1 * 33] * kq[1]); o.y = pk_bf16(s[2 * 33] * kq[2], s[3 * 33] * kq[3]); o.z = pk_bf16(s[4 * 33] * kq[4], s[5 * 33] * kq[5]); o.w = pk_bf16(s[6 * 33] * kq[6], s[7 * 33] * kq[7]);
        *(v4u*)(WT + (size_t)(dr0 + n) * K + k0 + 8 * c) = o; }
    asm volatile("s_waitcnt lgkmcnt(0)" ::: "memory");
}
__device__ __forceinline__ void tr_item_ada(const float* W, int K, int N, int k0, int sc0, bool perm, bf16* WT0, bf16* WT1, int dr0, LAS float* scr, int lane,
                                            const float* g, const float* scA, const float* scB, const float* shA, const float* shB, float* biasA, float* biasB) {
#pragma unroll 8
    for (int i = 0; i < 32; ++i) { const int kk = 2 * i + (lane >> 5); scr[kk * 33 + (lane & 31)] = W[(size_t)(k0 + kk) * N + sc0 + (lane & 31)]; }
    asm volatile("s_waitcnt lgkmcnt(0)" ::: "memory");
    const int c = lane & 7;
    float qa[8], qb[8];
#pragma unroll
    for (int e = 0; e < 8; ++e) { const int k = k0 + 8 * c + e; const float gk = g[k]; qa[e] = gk * (1.0f + scA[k]); qb[e] = gk * (1.0f + scB[k]); }
#pragma unroll
    for (int j = 0; j < 4; ++j) { const int n = (lane >> 3) + 8 * j; const int ci = perm ? permf(n) : n; const LAS float* s = scr + (8 * c) * 33 + ci;
        float t[8];
#pragma unroll
        for (int e = 0; e < 8; ++e) t[e] = s[e * 33];
        v4u o; o.x = pg8::pk_f16(t[0] * qa[0], t[1] * qa[1]); o.y = pg8::pk_f16(t[2] * qa[2], t[3] * qa[3]); o.z = pg8::pk_f16(t[4] * qa[4], t[5] * qa[5]); o.w = pg8::pk_f16(t[6] * qa[6], t[7] * qa[7]);
        *(v4u*)(WT0 + (size_t)(dr0 + n) * K + k0 + 8 * c) = o;
        v4u p; p.x = pg8::pk_f16(t[0] * qb[0], t[1] * qb[1]); p.y = pg8::pk_f16(t[2] * qb[2], t[3] * qb[3]); p.z = pg8::pk_f16(t[4] * qb[4], t[5] * qb[5]); p.w = pg8::pk_f16(t[6] * qb[6], t[7] * qb[7]);
        *(v4u*)(WT1 + (size_t)(dr0 + n) * K + k0 + 8 * c) = p; }
    { const int n32 = lane & 31, hf = lane >> 5; const int cb = perm ? permf(n32) : n32;
      float bA = 0.f, bB = 0.f;
#pragma unroll 8
      for (int kk = 0; kk < 32; ++kk) { const int k = hf * 32 + kk; const float w = scr[k * 33 + cb]; bA += shA[k0 + k] * w; bB += shB[k0 + k] * w; }
      bA += __shfl_xor(bA, 32); bB += __shfl_xor(bB, 32);
      if (hf == 0) { atomicAdd(biasA + dr0 + n32, bA); atomicAdd(biasB + dr0 + n32, bB); } }
    asm volatile("s_waitcnt lgkmcnt(0)" ::: "memory");
}
__device__ __forceinline__ void win_src(int n0, int& sc0, bool& perm) {
    const int tile = n0 >> 8, bj = (n0 >> 7) & 1, w = n0 & 127;
    if (tile < 5 || (tile == 5 && bj == 0)) { sc0 = n0; perm = false; }
    else if (tile == 5) { sc0 = 1920 + w; perm = false; }
    else { const int s = w >> 5; const int hb = (tile == 6) ? 1408 + 64 * s : (s < 2 ? 1408 + 64 * (4 + s) : 1792 + 64 * (s - 2)); sc0 = hb + 32 * bj; perm = true; }
}

struct Args { const float* in[17]; float* out; unsigned char* ws; int ph_lo, ph_hi; };
enum { I_X = 0, I_C, I_WMOD, I_BMOD, I_GATTN, I_WIN, I_RPB, I_SINK, I_T5, I_GQ, I_GK, I_GGROUP, I_WO, I_GFFN, I_WGU, I_WDOWN, I_GFINAL };

__device__ __forceinline__ void phase_prep(const Args& a, LAS unsigned char* lds, int tid, int lane, int wave) {
    unsigned char* ws = a.ws;
    const int G = gridDim.x;
    for (int it = blockIdx.x; it < 192; it += G) {
        const int l = it / 96, j0 = (it % 96) * 64;
        const float* W = a.in[I_WMOD] + (size_t)l * 1024 * 6144 + j0 + lane;
        const float* c0 = a.in[I_C]; const float* c1 = c0 + 1024;
        float a0 = 0.f, a1 = 0.f;
        const int kb = wave * 128;
#pragma unroll 32
        for (int k = 0; k < 128; ++k) {
            const float w = W[(size_t)(kb + k) * 6144];
            const float x0 = c0[kb + k], x1 = c1[kb + k];
            a0 += w * (x0 / (1.0f + __expf(-x0))); a1 += w * (x1 / (1.0f + __expf(-x1)));
        }
        LAS float* red = (LAS float*)lds;
        red[(wave * 2 + 0) * 64 + lane] = a0; red[(wave * 2 + 1) * 64 + lane] = a1;
        __syncthreads();
        if (wave < 2) { float s = 0.f;
#pragma unroll
            for (int w8 = 0; w8 < 8; ++w8) s += red[(w8 * 2 + wave) * 64 + lane];
            s += a.in[I_BMOD][l * 6144 + j0 + lane];
            ((float*)(ws + WS_MOD))[(size_t)(l * 2 + wave) * 6144 + j0 + lane] = s; }
        __syncthreads();
    }
    for (int i = blockIdx.x * 512 + tid + MT / 4; i < 5 * MT / 4; i += G * 512) ((f32x4*)(ws + WS_ROWSS))[i] = (f32x4){0.f, 0.f, 0.f, 0.f};
    for (int i = blockIdx.x * 512 + tid; i < 6 * MT / 4; i += G * 512) ((f32x4*)(ws + WS_GSS))[i] = (f32x4){0.f, 0.f, 0.f, 0.f};
    for (int i = blockIdx.x * 512 + tid; i < (120 * 1024) / 16; i += G * 512) ((f32x4*)(ws + WS_BIASIN))[i] = (f32x4){0.f, 0.f, 0.f, 0.f};
    const int gt = blockIdx.x * 512 + tid;
    if (gt < 4096) { const int pos = gt >> 4, f = gt & 15; const float fr = exp2f(-(float)f * (13.287712379549449f / 16.0f)); const float ang = (float)pos * fr;
        ((float*)(ws + WS_ROPEC))[gt] = cosf(ang); ((float*)(ws + WS_ROPES))[gt] = sinf(ang); }
    if (gt >= 4096 && gt < 4096 + 6 * 257) { const int e = gt - 4096, h = e / 257, r = e % 257; const int rel = r - 128; const int n = rel < 0 ? -rel : rel;
        int bk = rel > 0 ? 16 : 0; int lg = n < 8 ? n : 8 + ((31 - __builtin_clz((unsigned)(n * n))) - 6); if (lg > 15) lg = 15; bk += lg;
        ((float*)(ws + WS_SWB))[h * 260 + r] = a.in[I_T5][bk * 6 + h] * LOG2E_; }
    if (gt >= 5900 && gt < 5900 + 32) ((unsigned*)(ws + WS_KMAX))[gt - 5900] = 0u;
    if (gt >= 5800 && gt < 5800 + DEPTH_) { const int l = gt - 5800; float gqm = 0.f, gkm = 0.f;
        for (int i = 0; i < 64; ++i) { gqm = fmaxf(gqm, fabsf(a.in[I_GQ][l * 64 + i])); gkm = fmaxf(gkm, fabsf(a.in[I_GK][l * 64 + i])); }
        ((float*)(ws + WS_MREF))[l] = fminf(8.0f * gqm * gkm * LOG2E_ * 1.02f, 100.0f); }
    { const int gw = blockIdx.x * 8 + wave, NGW = G * 8;
      const float* x = a.in[I_X]; float* rowss = (float*)(ws + WS_ROWSS);
      for (int blk = gw; blk < MT / 16; blk += NGW) {
        const int r0 = blk * 16;
#pragma unroll 2
        for (int r = 0; r < 16; ++r) {
            const f32x4* xr = (const f32x4*)(x + (size_t)(r0 + r) * 1024) + lane;
            f32x4 v[4]; float s_ = 0.f;
#pragma unroll
            for (int j = 0; j < 4; ++j) { v[j] = xr[64 * j]; s_ += (v[j][0] * v[j][0] + v[j][1] * v[j][1]) + (v[j][2] * v[j][2] + v[j][3] * v[j][3]); }
            s_ = wave_sum(s_);
            if (lane == 0) rowss[r0 + r] = s_;
            v2u* x8 = (v2u*)((bf16*)(ws + WS_H) + (size_t)(r0 + r) * 1024) + lane;
#pragma unroll
            for (int j = 0; j < 4; ++j) { v2u wx; wx.x = pg8::pk_f16(v[j][0], v[j][1]); wx.y = pg8::pk_f16(v[j][2], v[j][3]); x8[64 * j] = wx; }
        }
      } }
}

__device__ __forceinline__ void phase_p1(const Args& a, LAS unsigned char* lds, int lane, int wave) {
    unsigned char* ws = a.ws;
    const float* mod = (const float*)(ws + WS_MOD);
    LAS float* scr = (LAS float*)(lds + wave * 16384);
    const int gw = blockIdx.x * 8 + wave, NGW = gridDim.x * 8;
    constexpr int IT_IN = 16 * 64, IT_O = 16 * 32, IT_GU = 16 * 176, IT_DN = 44 * 32, IT_L = IT_IN + IT_O + IT_GU + IT_DN;
    for (int it = gw; it < 2 * IT_L; it += NGW) {
        const int l = it / IT_L; int r = it % IT_L;
        const float* md = mod + (size_t)l * 2 * 6144;
        if (r < IT_IN) { const int kb = r >> 6, nb = r & 63; int sc0; bool perm; win_src(nb * 32, sc0, perm);
            bf16* wt = (bf16*)(ws + WS_WIN) + (size_t)l * 2 * 2048 * 1024;
            tr_item_ada(a.in[I_WIN] + (size_t)l * 1024 * 2048, 1024, 2048, kb * 64, sc0, perm, wt, wt + (size_t)2048 * 1024, nb * 32, scr, lane,
                        a.in[I_GATTN] + l * 1024, md + 1024, md + 6144 + 1024, md, md + 6144, (float*)(ws + WS_BIASIN) + (size_t)l * 2 * 2048, (float*)(ws + WS_BIASIN) + (size_t)l * 2 * 2048 + 2048); continue; }
        r -= IT_IN;
        if (r < IT_O) { const int kb = r >> 5, nb = r & 31;
            tr_item(a.in[I_WO] + (size_t)l * 1024 * 1024, 1024, 1024, kb * 64, nb * 32, false, (bf16*)(ws + WS_WO) + (size_t)l * 1024 * 1024, nb * 32, scr, lane, a.in[I_GGROUP] + l * 1024); continue; }
        r -= IT_O;
        if (r < IT_GU) { const int kb = r / 176, nb = r % 176; const int n0 = nb * 32; const int sc0 = ((n0 >> 7) & 1) * 2816 + (n0 >> 8) * 128 + (n0 & 127);
            bf16* wt = (bf16*)(ws + WS_WGU) + (size_t)l * 2 * 5632 * 1024;
            tr_item_ada(a.in[I_WGU] + (size_t)l * 1024 * 5632, 1024, 5632, kb * 64, sc0, false, wt, wt + (size_t)5632 * 1024, n0, scr, lane,
                        a.in[I_GFFN] + l * 1024, md + 4096, md + 6144 + 4096, md + 3072, md + 6144 + 3072, (float*)(ws + WS_BIASGU) + (size_t)l * 2 * 5632, (float*)(ws + WS_BIASGU) + (size_t)l * 2 * 5632 + 5632); continue; }
        r -= IT_GU;
        { const int kb = r >> 5, nb = r & 31;
            tr_item(a.in[I_WDOWN] + (size_t)l * 2816 * 1024, 2816, 1024, kb * 64, nb * 32, false, (bf16*)(ws + WS_WDN) + (size_t)l * 1024 * 2816, nb * 32, scr, lane); }
    }
}
__device__ __forceinline__ void phase_final(const bf16* xb, float* out, const float* g, const float* rowss, int lane, int wave) {
    const int gw = blockIdx.x * 8 + wave, NGW = gridDim.x * 8;
    f32x4 gv[4];
#pragma unroll
    for (int j = 0; j < 4; ++j) gv[j] = *(const f32x4*)(g + 16 * lane + 4 * j);
    for (int row = gw; row < MT; row += NGW) {
        const v4u* xr = (const v4u*)(xb + (size_t)row * 1024 + 16 * lane);
        const v4u w0 = xr[0], w1 = xr[1];
        const float rinv = rsqrtf(rowss[row] * (1.0f / 1024.0f) + EPS_);
        f32x4* o = (f32x4*)(out + (size_t)row * 1024 + 16 * lane);
        { const pg8::f32x2 a0 = pg8::up_f16(w0.x), a1 = pg8::up_f16(w0.y), a2 = pg8::up_f16(w0.z), a3 = pg8::up_f16(w0.w);
          const pg8::f32x2 b0 = pg8::up_f16(w1.x), b1 = pg8::up_f16(w1.y), b2 = pg8::up_f16(w1.z), b3 = pg8::up_f16(w1.w);
          o[0] = (f32x4){a0[0], a0[1], a1[0], a1[1]} * rinv * gv[0]; o[1] = (f32x4){a2[0], a2[1], a3[0], a3[1]} * rinv * gv[1];
          o[2] = (f32x4){b0[0], b0[1], b1[0], b1[1]} * rinv * gv[2]; o[3] = (f32x4){b2[0], b2[1], b3[0], b3[1]} * rinv * gv[3]; }
    }
}
__device__ __forceinline__ float bf_lo(unsigned w) { return __uint_as_float(w << 16); }
__device__ __forceinline__ float bf_hi(unsigned w) { return __uint_as_float(w & 0xffff0000u); }
__device__ __forceinline__ void phase_gnorm(const bf16* y, const float* gg, bf16* yn, int lane, int wave) {
    const int gw = blockIdx.x * 8 + wave, NGW = gridDim.x * 8;
    float gv[16];
#pragma unroll
    for (int j = 0; j < 4; ++j) { const f32x4 t = *(const f32x4*)(gg + 16 * lane + 4 * j); gv[4 * j] = t[0]; gv[4 * j + 1] = t[1]; gv[4 * j + 2] = t[2]; gv[4 * j + 3] = t[3]; }
    const int grp = lane < 16 ? 0 : (lane < 40 ? 1 : 2);
    for (int row = gw; row < MT; row += NGW) {
        const v4u* yr = (const v4u*)(y + (size_t)row * 1024 + 16 * lane);
        const v4u w0 = yr[0], w1 = yr[1];
        float v[16];
        v[0] = bf_lo(w0.x); v[1] = bf_hi(w0.x); v[2] = bf_lo(w0.y); v[3] = bf_hi(w0.y); v[4] = bf_lo(w0.z); v[5] = bf_hi(w0.z); v[6] = bf_lo(w0.w); v[7] = bf_hi(w0.w);
        v[8] = bf_lo(w1.x); v[9] = bf_hi(w1.x); v[10] = bf_lo(w1.y); v[11] = bf_hi(w1.y); v[12] = bf_lo(w1.z); v[13] = bf_hi(w1.z); v[14] = bf_lo(w1.w); v[15] = bf_hi(w1.w);
        float s = 0.f;
#pragma unroll
        for (int j = 0; j < 16; ++j) s += v[j] * v[j];
        const float sA = wave_sum(grp == 0 ? s : 0.f), sB = wave_sum(grp == 1 ? s : 0.f), sC = wave_sum(grp == 2 ? s : 0.f);
        const float rinv = grp == 0 ? rsqrtf(sA * (1.0f / 256.0f) + EPS_) : (grp == 1 ? rsqrtf(sB * (1.0f / 384.0f) + EPS_) : rsqrtf(sC * (1.0f / 384.0f) + EPS_));
        v4u o0, o1;
        o0.x = pk_bf16(v[0] * rinv * gv[0], v[1] * rinv * gv[1]); o0.y = pk_bf16(v[2] * rinv * gv[2], v[3] * rinv * gv[3]);
        o0.z = pk_bf16(v[4] * rinv * gv[4], v[5] * rinv * gv[5]); o0.w = pk_bf16(v[6] * rinv * gv[6], v[7] * rinv * gv[7]);
        o1.x = pk_bf16(v[8] * rinv * gv[8], v[9] * rinv * gv[9]); o1.y = pk_bf16(v[10] * rinv * gv[10], v[11] * rinv * gv[11]);
        o1.z = pk_bf16(v[12] * rinv * gv[12], v[13] * rinv * gv[13]); o1.w = pk_bf16(v[14] * rinv * gv[14], v[15] * rinv * gv[15]);
        v4u* orow = (v4u*)(yn + (size_t)row * 1024 + 16 * lane);
        orow[0] = o0; orow[1] = o1;
    }
}

__device__ __forceinline__ int crow16(int i, int hi) { return (i & 3) + 8 * (i >> 2) + 4 * hi; }
template <int MODE>
__device__ __forceinline__ void small_attn_wave(const bf16* Qb, int qpitch, const bf16* Kp, const bf16* Vp, int kvpitch, bf16* Ob,
                                                int qt  , int qcol0, const float* gtab, int ntab, float tabscale, float sink2,
                                                float* gssrow, const unsigned* kmax2, LAS unsigned char* wl, int lane) {
    const int r32 = lane & 31, hi = lane >> 5;
    LAS float* tab = (LAS float*)(wl + 9216);
    const int qrow = qt + (r32 >> 4), qc = qcol0 + (r32 & 15);
    const int qtok = MODE == 0 ? qt + r32 : qrow * 64 + qc;
    bf16x8 qf[4];
#pragma unroll
    for (int ks = 0; ks < 4; ++ks) qf[ks] = *(const bf16x8*)(Qb + (size_t)qtok * qpitch + 16 * ks + 8 * hi);
    int nt, tb0, tstep, rsA = 0, kc0 = 0, my_rs = 0, my_cs = 0;
    if (MODE == 0) { const int t0 = qt - 128 < 0 ? 0 : qt - 128; const int t1 = qt + 160 > SEQ_ ? SEQ_ : qt + 160; tb0 = t0; nt = (t1 - t0) >> 5; tstep = 32; }
    else { rsA = qt - 4; rsA = rsA < 0 ? 0 : (rsA > 248 ? 248 : rsA); int rsB = qt - 3; rsB = rsB < 0 ? 0 : (rsB > 248 ? 248 : rsB); nt = 8 + (rsB - rsA);
        kc0 = qcol0 - 8; kc0 = kc0 < 0 ? 0 : (kc0 > 32 ? 32 : kc0); tb0 = rsA * 64 + kc0; tstep = 64;
        my_rs = qrow - 4; my_rs = my_rs < 0 ? 0 : (my_rs > 248 ? 248 : my_rs); my_cs = qc - 8; my_cs = my_cs < 0 ? 0 : (my_cs > 48 ? 48 : my_cs); }
    bf16x8 kf[4]; v4u vr[4];
#define SA_LOAD(tbase) do { const bf16* kp_ = Kp + (size_t)((tbase) + r32) * kvpitch + 8 * hi; \
        _Pragma("unroll") for (int ks = 0; ks < 4; ++ks) kf[ks] = *(const bf16x8*)(kp_ + 16 * ks); \
        _Pragma("unroll") for (int e = 0; e < 4; ++e) { const int c = lane + 64 * e; vr[e] = *(const v4u*)(Vp + (size_t)((tbase) + (c >> 3)) * kvpitch + (c & 7) * 8); } } while (0)
#define SA_VWRITE(buf) do { _Pragma("unroll") for (int e = 0; e < 4; ++e) { const int c = lane + 64 * e; *(LAS v4u*)(wl + (buf) * 4608 + (c >> 3) * 144 + (c & 7) * 16) = vr[e]; } } while (0)
#define SA_QK(X) do { _Pragma("unroll") for (int ks = 0; ks < 4; ++ks) X = __builtin_amdgcn_mfma_f32_32x32x16_bf16(kf[ks], qf[ks], X, 0, 0, 0); } while (0)
#define SA_CINIT(ti, X) do { const int tbc = tb0 + tstep * (ti); \
        if (MODE == 0) { const int relb = tbc - qtok + 4 * hi; const int d = tbc - qt; \
            if (d >= -96 && d <= 96) { const LAS float* tp = tab + (relb + 128); \
                _Pragma("unroll") for (int e = 0; e < 16; ++e) X[e] = tp[(e & 3) + 8 * (e >> 2)]; \
            } else { \
                _Pragma("unroll") for (int e = 0; e < 16; ++e) { const int rel = relb + (e & 3) + 8 * (e >> 2); const bool ok = (unsigned)(rel + 128) <= 256u; \
                    const int idx = ok ? rel + 128 : 0; X[e] = ok ? tab[idx] : -1e30f; } } \
        } else { \
            const int kr = rsA + (ti); const bool rowok = (unsigned)(kr - my_rs) < 8u; const int colb = kc0 + 4 * hi - my_cs; \
            int ib = (kr - qrow + 7) * 31 + kc0 + 4 * hi - qc + 15; ib = rowok ? ib : 0; \
            _Pragma("unroll") for (int e = 0; e < 16; ++e) { const int cc = (e & 3) + 8 * (e >> 2); const bool ok = rowok && ((unsigned)(colb + cc) < 16u); \
                const int idx = ok ? ib + cc : 0; X[e] = ok ? tab[idx] : -1e30f; } \
        } } while (0)
    SA_LOAD(tb0);
    float bmx = -1e30f;
    for (int e = lane; e < ntab; e += 64) { const float tv_ = gtab[e] * tabscale; tab[e] = tv_; bmx = fmaxf(bmx, tv_); }
#pragma unroll
    for (int o_ = 1; o_ < 64; o_ <<= 1) bmx = fmaxf(bmx, __shfl_xor(bmx, o_));
    float ref;
    { float qs = 0.f;
#pragma unroll
      for (int ks = 0; ks < 4; ++ks) { const v4u qw = __builtin_bit_cast(v4u, qf[ks]);
#pragma unroll
          for (int e = 0; e < 4; ++e) { const float lo_ = __uint_as_float(qw[e] << 16), hi_ = __uint_as_float(qw[e] & 0xffff0000u); qs += lo_ * lo_ + hi_ * hi_; } }
      auto rr = __builtin_amdgcn_permlane32_swap(__float_as_uint(qs), __float_as_uint(qs), false, false); qs = __uint_as_float(rr[0]) + __uint_as_float(rr[1]);
      const float k2 = __uint_as_float(kmax2[0]) + __uint_as_float(kmax2[1]);
      ref = fminf(__builtin_sqrtf(qs * k2) * 1.03f + bmx, 110.0f); }
    f32x16 o0 = {}, o1 = {};
    float lsum = 0.f;
    const int i16 = lane & 15, g16 = (lane >> 4) & 1;
    LAS unsigned char* vaddr = wl + (4 * hi + (i16 >> 2)) * 144 + g16 * 32 + 8 * (i16 & 3);
    f32x16 xa_, xb_;
    SA_VWRITE(0); SA_CINIT(0, xa_); SA_QK(xa_);
    if (nt > 1) SA_LOAD(tb0 + tstep);
#define SA_TILE(i, X, XN) do { \
        const int tb = tb0 + tstep * (i); \
        if ((i) + 1 < nt) { SA_VWRITE(((i) + 1) & 1); SA_CINIT((i) + 1, XN); SA_QK(XN); if ((i) + 2 < nt) SA_LOAD(tb + 2 * tstep); } \
        float ps = 0.f; \
        _Pragma("unroll") for (int e = 0; e < 16; ++e) { const float p_ = __builtin_amdgcn_exp2f(X[e] - ref); X[e] = p_; ps += p_; } \
        lsum += ps; \
        v4u pw0, pw1; \
        pw0.x = pk_bf16(X[0], X[1]); pw0.y = pk_bf16(X[2], X[3]); pw0.z = pk_bf16(X[4], X[5]); pw0.w = pk_bf16(X[6], X[7]); \
        pw1.x = pk_bf16(X[8], X[9]); pw1.y = pk_bf16(X[10], X[11]); pw1.z = pk_bf16(X[12], X[13]); pw1.w = pk_bf16(X[14], X[15]); \
        const bf16x8 pb0 = __builtin_bit_cast(bf16x8, pw0), pb1 = __builtin_bit_cast(bf16x8, pw1); \
        asm volatile("s_waitcnt lgkmcnt(0)" ::: "memory"); \
        LAS unsigned char* va_ = vaddr + ((i) & 1) * 4608; \
        { const s16x4 a0 = TRR(va_, 0), a1 = TRR(va_, 8 * 144), b0 = TRR(va_, 16 * 144), b1 = TRR(va_, 24 * 144); \
          o0 = __builtin_amdgcn_mfma_f32_32x32x16_bf16(CAT(a0, a1), pb0, o0, 0, 0, 0); \
          o0 = __builtin_amdgcn_mfma_f32_32x32x16_bf16(CAT(b0, b1), pb1, o0, 0, 0, 0); } \
        { const s16x4 a0 = TRR(va_, 64), a1 = TRR(va_, 64 + 8 * 144), b0 = TRR(va_, 64 + 16 * 144), b1 = TRR(va_, 64 + 24 * 144); \
          o1 = __builtin_amdgcn_mfma_f32_32x32x16_bf16(CAT(a0, a1), pb0, o1, 0, 0, 0); \
          o1 = __builtin_amdgcn_mfma_f32_32x32x16_bf16(CAT(b0, b1), pb1, o1, 0, 0, 0); } \
        asm volatile("s_waitcnt lgkmcnt(0)" ::: "memory"); \
    } while (0)
    typedef short v4i16_t __attribute__((ext_vector_type(4)));
#define TRR(base, off) __builtin_bit_cast(s16x4, __builtin_amdgcn_ds_read_tr16_b64_v4i16((LAS v4i16_t*)((base) + (off))))
#define CAT(a, b) (bf16x8){a[0], a[1], a[2], a[3], b[0], b[1], b[2], b[3]}
    for (int i = 0; i < nt; i += 2) {
        SA_TILE(i, xa_, xb_);
        if (i + 1 < nt) SA_TILE(i + 1, xb_, xa_);
    }
#undef TRR
#undef CAT
#undef SA_TILE
#undef SA_QK
#undef SA_CINIT
#undef SA_VWRITE
#undef SA_LOAD
    { auto rr = __builtin_amdgcn_permlane32_swap(__float_as_uint(lsum), __float_as_uint(lsum), false, false); lsum = __uint_as_float(rr[0]) + __uint_as_float(rr[1]); }
    if (MODE == 0) lsum += __builtin_amdgcn_exp2f(sink2 - ref);
    const float inv = 1.0f / lsum;
    { float ss = 0.f;
#pragma unroll
      for (int e = 0; e < 16; ++e) { const float a0 = o0[e] * inv, a1 = o1[e] * inv; ss += a0 * a0 + a1 * a1; }
      auto rr = __builtin_amdgcn_permlane32_swap(__float_as_uint(ss), __float_as_uint(ss), false, false); ss = __uint_as_float(rr[0]) + __uint_as_float(rr[1]);
      if (hi == 0) atomicAdd(gssrow + qtok, ss); }
    bf16* orow = Ob + (size_t)qtok * 1024 + 4 * hi;
#pragma unroll
    for (int gq = 0; gq < 4; ++gq) {
        v2u w; w.x = pk_bf16(o0[4 * gq] * inv, o0[4 * gq + 1] * inv); w.y = pk_bf16(o0[4 * gq + 2] * inv, o0[4 * gq + 3] * inv); *(v2u*)(orow + 8 * gq) = w;
        v2u w2; w2.x = pk_bf16(o1[4 * gq] * inv, o1[4 * gq + 1] * inv); w2.y = pk_bf16(o1[4 * gq + 2] * inv, o1[4 * gq + 3] * inv); *(v2u*)(orow + 32 + 8 * gq) = w2;
    }
}

#ifndef PROBE_SYNC
#define PROBE_SYNC 0
#endif
#ifndef PROBE_MISC
#define PROBE_MISC 0
#endif
#ifndef PROBE_GU
#define PROBE_GU 0
#endif
#ifndef PROBE_DENSE
#define PROBE_DENSE 1
#endif
#ifndef PROBE_SMALL
#define PROBE_SMALL 1
#endif
__global__ void __launch_bounds__(512) mega_fwd(Args args) {
    extern __shared__ __attribute__((aligned(16))) unsigned char lds_raw[];
    LAS unsigned char* lds = (LAS unsigned char*)lds_raw;
    cg::grid_group grid = cg::this_grid();
    volatile LAS unsigned* MISC = (volatile LAS unsigned*)(lds + 131072);
    if (threadIdx.x < 16) MISC[threadIdx.x] = 0u;
    __syncthreads();
    XcdBarrier xbar = xcd_barrier_post((unsigned*)(args.ws + WS_BAR), MISC + 8);
#define FRESH() int t_ = threadIdx.x; asm volatile("" : "+v"(t_)); const int tid = t_, lane = t_ & 63, wave = __builtin_amdgcn_readfirstlane(t_ >> 6); (void)tid; (void)lane; (void)wave
    const int G = gridDim.x;
    unsigned char* ws = args.ws;
    const int lo = args.ph_lo, hi = args.ph_hi;
    float* xres = args.out;
    const float* modp = (const float*)(ws + WS_MOD);
    bf16* HB = (bf16*)(ws + WS_H);     bf16* QKV = (bf16*)(ws + WS_QKV); bf16* YB = (bf16*)(ws + WS_Y); bf16* ACT = (bf16*)(ws + WS_ACT);
    int ph = 0;
#define IN_(k) (lo <= (k) && (k) < hi)
#define SEAM(k) do { if (IN_(k) && IN_((k) + 1)) { if (args.ph_lo < 0) grid.sync();   xcd_barrier(xbar); for (int e_ = 0; e_ < PROBE_SYNC; ++e_) xcd_barrier(xbar); } } while (0)

    if (IN_(ph)) { FRESH(); phase_prep(args, lds, tid, lane, wave);
#if PROBE_MISC
        __syncthreads(); phase_prep(args, lds, tid, lane, wave);
#endif
    }
    SEAM(ph); ++ph;
    if (IN_(ph)) { FRESH(); phase_p1(args, lds, lane, wave);
#if PROBE_MISC
        phase_p1(args, lds, lane, wave);
#endif
    }
    SEAM(ph); ++ph;
    float* ROWSS = (float*)(ws + WS_ROWSS); float* GSS = (float*)(ws + WS_GSS);

    for (int l = 0; l < DEPTH_; ++l) {
        const float* mod_l = modp + (size_t)l * 2 * 6144;
        const float* xin = (l == 0) ? args.in[I_X] : xres;
        if (IN_(ph)) {
            pg8::Gemm g{HB, (const bf16*)(ws + WS_WIN) + (size_t)l * 2 * 2048 * 1024, MT, INW, 1024, (size_t)2048 * 1024 * 2, 64};     pg8::StaticOrder S; S.init(MT, INW, G, (int)blockIdx.x, 1);
            pg8::EpiInProj E{QKV, (const float*)(ws + WS_ROPEC), (const float*)(ws + WS_ROPES), args.in[I_GQ] + l * 64, args.in[I_GK] + l * 64, ROWSS + (size_t)(2 * l) * MT, (const float*)(ws + WS_BIASIN) + (size_t)l * 2 * 2048, (unsigned*)(ws + WS_KMAX) + (size_t)l * 16};
            pg8::gemm_phase<pg8::EpiInProj, pg8::StaticOrder, true, true, true>(lds, g, S, E);
        }
        SEAM(ph); ++ph;
        if (IN_(ph)) {
            for (int rep = 0; rep < PROBE_DENSE; ++rep)
            for (int ui = 0, u = blockIdx.x; u < 768; u += G, ++ui) {
                int qb = u & 63, h3 = (u >> 6) % 3, kvh = (u / 192) & 1, b = u / 384;
                if (G == 256) { const int xcd = blockIdx.x & 7, j = blockIdx.x >> 3;
                    b = (xcd >> 1) & 1; kvh = xcd & 1; h3 = ui; qb = (xcd >> 2) * 32 + j; }
                attn_body::attn_unit<8>(b, kvh * 3 + h3, qb, (const attn_body::bf16*)(QKV + pg8::OFF_QC), (const attn_body::bf16*)(QKV + pg8::OFF_KC),
                                        (const attn_body::bf16*)(QKV + pg8::OFF_VC), (attn_body::bf16*)(YB + 640), GSS + (size_t)(l * 3 + 2) * MT, ((const float*)(ws + WS_MREF))[l], (char*)lds_raw);
            }
            __syncthreads();
            FRESH();
            LAS unsigned char* wl = lds + wave * 11264;
            for (int uu = blockIdx.x; uu < 768 * PROBE_SMALL; uu += G) {
                const int u = uu % 768; const int qb = u & 63, h = (u >> 6) % 6, b = u / 384; const int qt = qb * 256 + wave * 32; const size_t rb = (size_t)b * SEQ_;
                small_attn_wave<0>(QKV + pg8::OFF_QB + rb * 384 + h * 64, 384, QKV + pg8::OFF_KB + rb * 128 + (h / 3) * 64, QKV + pg8::OFF_VB + rb * 128 + (h / 3) * 64, 128,
                                   YB + rb * 1024 + 256 + h * 64, qt, 0, (const float*)(ws + WS_SWB) + h * 260, 257, 1.0f, args.in[I_SINK][l * 6 + h] * LOG2E_, GSS + (size_t)(l * 3 + 1) * MT + rb, (const unsigned*)(ws + WS_KMAX) + ((l * 2 + 1) * 4 + h / 3) * 2, wl, lane);
            }
            for (int uu = blockIdx.x; uu < 512 * PROBE_SMALL; uu += G) {
                const int u = uu & 511; const int qb = u & 63, h = (u >> 6) & 3, b = u >> 8; const size_t rb = (size_t)b * SEQ_;
                small_attn_wave<1>(QKV + pg8::OFF_QA + rb * 256 + h * 64, 256, QKV + pg8::OFF_KA + rb * 256 + h * 64, QKV + pg8::OFF_VA + rb * 256 + h * 64, 256,
                                   YB + rb * 1024 + h * 64, qb * 4 + 2 * (wave >> 2), 16 * (wave & 3), args.in[I_RPB] + (size_t)(l * 4 + h) * 465, 465, LOG2E_, 0.f, GSS + (size_t)(l * 3 + 0) * MT + rb, (const unsigned*)(ws + WS_KMAX) + ((l * 2 + 0) * 4 + h) * 2, wl, lane);
            }
            __syncthreads();
        }
        SEAM(ph); ++ph;
        if (IN_(ph)) {
            pg8::Gemm g{YB, (const bf16*)(ws + WS_WO) + (size_t)l * 1024 * 1024, MT, 1024, 1024, 0, 1 << 30}; pg8::StaticOrder S; S.init(MT, 1024, G, (int)blockIdx.x);
            pg8::EpiResid<true> E{HB, HB, mod_l + 2048, 6144, ROWSS + (size_t)(2 * l + 1) * MT, GSS + (size_t)(l * 3) * MT};
            pg8::gemm_phase<pg8::EpiResid<true>, pg8::StaticOrder, true, true>(lds, g, S, E);
        }
        SEAM(ph); ++ph;
        if (IN_(ph)) {
            pg8::Gemm g{HB, (const bf16*)(ws + WS_WGU) + (size_t)l * 2 * 5632 * 1024, MT, 5632, 1024, (size_t)5632 * 1024 * 2, 64}; pg8::StaticOrder S; S.init(MT, 5632, G, (int)blockIdx.x);
            pg8::EpiSwiGLU E{ACT, ROWSS + (size_t)(2 * l + 1) * MT, (const float*)(ws + WS_BIASGU) + (size_t)l * 2 * 5632};
            pg8::gemm_phase<pg8::EpiSwiGLU, pg8::StaticOrder, true, true, true>(lds, g, S, E);
#if PROBE_GU
            pg8::gemm_phase<pg8::EpiSwiGLU, pg8::StaticOrder, true, true, true>(lds, g, S, E);
#endif
        }
        SEAM(ph); ++ph;
        if (IN_(ph)) {
            pg8::Gemm g{ACT, (const bf16*)(ws + WS_WDN) + (size_t)l * 1024 * 2816, MT, 1024, 2816, 0, 1 << 30}; pg8::StaticOrder S; S.init(MT, 1024, G, (int)blockIdx.x);
            pg8::EpiResid<false> E{HB, HB, mod_l + 5120, 6144, ROWSS + (size_t)(2 * l + 2) * MT, nullptr};
            pg8::gemm_phase<pg8::EpiResid<false>, pg8::StaticOrder, true, true>(lds, g, S, E);
        }
        SEAM(ph); ++ph;
    }
    if (IN_(ph)) { FRESH(); phase_final(HB, xres, args.in[I_GFINAL], ROWSS + (size_t)(2 * DEPTH_) * MT, lane, wave); }
#undef IN_
#undef SEAM
}

constexpr int N_PHASES = 2 + 5 * DEPTH_ + 1;
#ifndef MK_PER_PHASE
#define MK_PER_PHASE 0
#endif

extern "C" void kernel_launch(void* const* d_in, const int* in_sizes, int n_in, void* d_out, int out_size, void* d_ws, size_t ws_size, hipStream_t stream) {
    static int grid = 0;
    if (grid == 0) {
        if (n_in != 17 || out_size != MT * DM || ws_size < WS_END) { fprintf(stderr, "kernel_launch: unexpected shapes (n_in %d out %d ws %zu)\n", n_in, out_size, ws_size); grid = -1; return; }
        int dev = 0, cus = 0, per_cu = 0;
        hipGetDevice(&dev); hipDeviceGetAttribute(&cus, hipDeviceAttributeMultiprocessorCount, dev);
        if (hipFuncSetAttribute((const void*)mega_fwd, hipFuncAttributeMaxDynamicSharedMemorySize, LDS_BYTES) != hipSuccess) { fprintf(stderr, "kernel_launch: hipFuncSetAttribute failed\n"); grid = -1; return; }
        if (hipOccupancyMaxActiveBlocksPerMultiprocessor(&per_cu, (const void*)mega_fwd, 512, LDS_BYTES) != hipSuccess || per_cu < 1) { fprintf(stderr, "kernel_launch: occupancy query says %d\n", per_cu); per_cu = 1; }
        (void)hipGetLastError();
        grid = cus * 1;
        fprintf(stderr, "kernel_launch: grid %d (cus %d, per_cu %d)\n", grid, cus, per_cu);
    }
    if (grid < 0) return;
    if (hipMemsetAsync((char*)d_ws + WS_BAR, 0, 16384, stream) != hipSuccess) { fprintf(stderr, "kernel_launch: memset failed\n"); return; }
    Args a{};
    for (int i = 0; i < 17; ++i) a.in[i] = (const float*)d_in[i];
    a.out = (float*)d_out; a.ws = (unsigned char*)d_ws;
#if MK_PER_PHASE
    for (int p = 0; p < N_PHASES; ++p) { a.ph_lo = p; a.ph_hi = p + 1; hipLaunchKernelGGL(mega_fwd, dim3(grid), dim3(512), LDS_BYTES, stream, a); }
#else
    a.ph_lo = 0; a.ph_hi = N_PHASES;
    void* kargs[] = {&a};
    hipError_t e = hipLaunchCooperativeKernel((const void*)mega_fwd, dim3(grid), dim3(512), kargs, LDS_BYTES, stream);
    if (e != hipSuccess) fprintf(stderr, "kernel_launch: cooperative launch failed: %s (grid %d)\n", hipGetErrorString(e), grid);
#endif
}
```
